# Optimizing an MI355X kernel written in HIP

```python
import jax, jax.numpy as jnp
from jax import lax
import numpy as np

D_MODEL = 1024
BATCH = 16
SEQ = 2048
DEPTH = 2

CHUNK = 64
EPS = 1e-6

POOL_WINDOWS = (2, 4, 8, 16)
POOL_WIDTH = D_MODEL
POOL_GROUP = POOL_WIDTH // len(POOL_WINDOWS)

LRU_WIDTH = D_MODEL
LRU_BLOCKS = 16
LRU_BLOCK = LRU_WIDTH // LRU_BLOCKS
CONV_WIDTH = 4
LRU_C = 8.0

SB_HEADS = 8
SB_HEAD_DIM = 128
SB_WIDTH = SB_HEADS * SB_HEAD_DIM
Q_BLOCK = 128

N_BRANCH = 3
IN_COLS = POOL_WIDTH + LRU_WIDTH + 3 * SB_WIDTH + N_BRANCH * D_MODEL
D_FF = ((8 * D_MODEL + 3 * 256 - 1) // (3 * 256)) * 256

kernel_name = "hybrid_pool_rglru_stickbreak_block"


def rms_norm(x, g):
    x32 = x.astype(jnp.float32)
    y = x32 * lax.rsqrt(jnp.mean(x32 * x32, axis=-1, keepdims=True) + EPS)
    return (y * g.astype(jnp.float32)).astype(x.dtype)


def pool_mixer(u, w_pool, pool_scale):
    S = u.shape[1]
    u32 = u.astype(jnp.float32)
    pos = jnp.arange(1, S + 1, dtype=jnp.float32)[None, :, None]
    outs = []
    for g, w in enumerate(POOL_WINDOWS):
        ug = u32[..., g * POOL_GROUP:(g + 1) * POOL_GROUP]
        cs = jnp.cumsum(ug, axis=1)
        cs_lag = jnp.pad(cs, ((0, 0), (w, 0), (0, 0)))[:, :S]
        mean = (cs - cs_lag) / jnp.minimum(pos, float(w))
        outs.append(mean - ug)
    p = jnp.stack(outs, axis=2).astype(u.dtype)
    y = jnp.einsum('bsgi,gij->bsgj', p, w_pool)
    return y.reshape(u.shape) * pool_scale


def rglru_mixer(u, conv_w, conv_b, w_rg, b_rg, w_ig, b_ig, lru_lambda):
    B, S, _ = u.shape
    up = jnp.pad(u, ((0, 0), (CONV_WIDTH - 1, 0), (0, 0)))
    xc = conv_b + conv_w[0] * up[:, 0:S]
    for k in range(1, CONV_WIDTH):
        xc = xc + conv_w[k] * up[:, k:k + S]
    xb = xc.reshape(B, S, LRU_BLOCKS, LRU_BLOCK)
    r = jax.nn.sigmoid(jnp.einsum('bshi,hij->bshj', xb, w_rg).reshape(B, S, LRU_WIDTH) + b_rg)
    i = jax.nn.sigmoid(jnp.einsum('bshi,hij->bshj', xb, w_ig).reshape(B, S, LRU_WIDTH) + b_ig)
    log_a = (-LRU_C * r.astype(jnp.float32)) * jax.nn.softplus(-lru_lambda.astype(jnp.float32))
    a = jnp.exp(log_a)
    mult = jnp.sqrt(-jnp.expm1(2.0 * log_a))
    b = mult * (i * xc).astype(jnp.float32)

    def combine(c1, c2):
        a1, b1 = c1
        a2, b2 = c2
        return a1 * a2, a2 * b1 + b2

    _, h = lax.associative_scan(combine, (a, b), axis=1)
    return h.astype(u.dtype)


def stick_breaking_attention(q, k, v):
    B, S, H, Dh = q.shape
    scale = Dh ** -0.5
    outs = []
    for start in range(0, S, Q_BLOCK):
        end = start + Q_BLOCK
        qb = q[:, start:end]
        kb = k[:, :end]
        vb = v[:, :end]
        z = jnp.einsum('bqhd,bkhd->bhqk', qb, kb).astype(jnp.float32) * scale
        qpos = jnp.arange(start, end)[:, None]
        kpos = jnp.arange(end)[None, :]
        causal = kpos < qpos
        log_beta = jax.nn.log_sigmoid(z)
        log_keep = jnp.where(causal, jax.nn.log_sigmoid(-z), 0.0)
        after = lax.cumsum(log_keep, axis=3, reverse=True) - log_keep
        w = jnp.where(causal, jnp.exp(log_beta + after), 0.0)
        outs.append(jnp.einsum('bhqk,bkhd->bqhd', w.astype(v.dtype), vb))
    return jnp.concatenate(outs, axis=1)


def setup_inputs(seed: int = 0) -> dict:
    key = jax.random.key(seed)
    ks = jax.random.split(key, 24)
    f32 = jnp.float32
    nrm = lambda k, shape, s: jax.random.normal(k, shape, f32) * s
    u = jax.random.uniform(ks[13], (DEPTH, LRU_WIDTH), f32, minval=0.9, maxval=0.999)
    p = u ** (1.0 / LRU_C)
    lru_lambda = jnp.log(p) - jnp.log1p(-p)
    return {
        "x": nrm(ks[0], (BATCH, SEQ, D_MODEL), 1.0),
        "norm_mix": 1.0 + nrm(ks[1], (DEPTH, D_MODEL), 0.02),
        "w_in": nrm(ks[2], (DEPTH, D_MODEL, IN_COLS), D_MODEL ** -0.5),
        "b_gate": nrm(ks[3], (DEPTH, N_BRANCH * D_MODEL), 0.01),
        "w_pool": nrm(ks[4], (DEPTH, len(POOL_WINDOWS), POOL_GROUP, POOL_GROUP), POOL_GROUP ** -0.5),
        "pool_scale": 1.0 + nrm(ks[5], (DEPTH, POOL_WIDTH), 0.1),
        "conv_w": nrm(ks[6], (DEPTH, CONV_WIDTH, LRU_WIDTH), CONV_WIDTH ** -0.5),
        "conv_b": nrm(ks[7], (DEPTH, LRU_WIDTH), 0.01),
        "w_rg": nrm(ks[8], (DEPTH, LRU_BLOCKS, LRU_BLOCK, LRU_BLOCK), LRU_BLOCK ** -0.5),
        "b_rg": nrm(ks[9], (DEPTH, LRU_WIDTH), 0.01),
        "w_ig": nrm(ks[10], (DEPTH, LRU_BLOCKS, LRU_BLOCK, LRU_BLOCK), LRU_BLOCK ** -0.5),
        "b_ig": nrm(ks[11], (DEPTH, LRU_WIDTH), 0.01),
        "lru_lambda": lru_lambda,
        "q_norm": 1.0 + nrm(ks[14], (DEPTH, SB_HEAD_DIM), 0.02),
        "k_norm": 1.0 + nrm(ks[15], (DEPTH, SB_HEAD_DIM), 0.02),
        "w_branch": nrm(ks[16], (DEPTH, N_BRANCH, D_MODEL, D_MODEL), D_MODEL ** -0.5),
        "w_out": nrm(ks[17], (DEPTH, D_MODEL, D_MODEL), D_MODEL ** -0.5),
        "norm_ffn": 1.0 + nrm(ks[18], (DEPTH, D_MODEL), 0.02),
        "w_ffn_gate": nrm(ks[19], (DEPTH, D_MODEL, D_FF), D_MODEL ** -0.5),
        "w_ffn_up": nrm(ks[20], (DEPTH, D_MODEL, D_FF), D_MODEL ** -0.5),
        "w_ffn_down": nrm(ks[21], (DEPTH, D_FF, D_MODEL), D_FF ** -0.5),
    }


def reference(x, norm_mix, w_in, b_gate, w_pool, pool_scale, conv_w, conv_b, w_rg, b_rg,
              w_ig, b_ig, lru_lambda, q_norm, k_norm, w_branch, w_out, norm_ffn,
              w_ffn_gate, w_ffn_up, w_ffn_down):
    B, S, _ = x.shape
    splits = np.cumsum([POOL_WIDTH, LRU_WIDTH, SB_WIDTH, SB_WIDTH, SB_WIDTH]).tolist()
    for l in range(DEPTH):
        h = rms_norm(x, norm_mix[l])
        proj = jnp.einsum('bsd,dc->bsc', h, w_in[l])
        u_pool, u_lru, q, k, v, g_logits = jnp.split(proj, splits, axis=-1)
        gates = jax.nn.sigmoid(g_logits + b_gate[l]).reshape(B, S, N_BRANCH, D_MODEL)

        y_pool = pool_mixer(u_pool, w_pool[l], pool_scale[l])
        y_lru = rglru_mixer(u_lru, conv_w[l], conv_b[l], w_rg[l], b_rg[l],
                            w_ig[l], b_ig[l], lru_lambda[l])
        qh = rms_norm(q.reshape(B, S, SB_HEADS, SB_HEAD_DIM), q_norm[l])
        kh = rms_norm(k.reshape(B, S, SB_HEADS, SB_HEAD_DIM), k_norm[l])
        vh = v.reshape(B, S, SB_HEADS, SB_HEAD_DIM)
        y_sb = stick_breaking_attention(qh, kh, vh).reshape(B, S, SB_WIDTH)

        merged = (gates[:, :, 0] * jnp.einsum('bsc,cd->bsd', y_pool, w_branch[l, 0])
                  + gates[:, :, 1] * jnp.einsum('bsc,cd->bsd', y_lru, w_branch[l, 1])
                  + gates[:, :, 2] * jnp.einsum('bsc,cd->bsd', y_sb, w_branch[l, 2]))
        x = x + jnp.einsum('bsd,de->bse', merged, w_out[l])

        h2 = rms_norm(x, norm_ffn[l])
        act = jax.nn.silu(jnp.einsum('bsd,df->bsf', h2, w_ffn_gate[l])) * jnp.einsum('bsd,df->bsf', h2, w_ffn_up[l])
        x = x + jnp.einsum('bsf,fd->bsd', act, w_ffn_down[l])
    return x
```

```cpp
#include <hip/hip_runtime.h>
#include <hip/hip_cooperative_groups.h>
#include <cstdio>
#include <cstdint>
namespace cg = cooperative_groups;

#define LAS __attribute__((address_space(3)))
typedef unsigned short bf16_t;
typedef short bf16x8 __attribute__((ext_vector_type(8)));
typedef float f32x4 __attribute__((ext_vector_type(4)));
typedef float f32x16 __attribute__((ext_vector_type(16)));
typedef unsigned u32x4 __attribute__((ext_vector_type(4)));
typedef unsigned u32x2 __attribute__((ext_vector_type(2)));

constexpr int BATCH = 16, SEQ = 2048, DM = 1024, MTOK = BATCH * SEQ, NH = 8, HD = 128, DFF = 2816, NGU = 2 * DFF, NLAYER = 2;
constexpr float EPS = 1e-6f;
#ifndef DBG_HI
#define DBG_HI 20
#define DBG_ADD 0.f
#define DBG_SLOT (-1)
#define DBG_OUT_OFF 0
#endif
constexpr size_t MiB = 1u << 20;
constexpr size_t SLOT_BYTES = 64 * MiB, SLOT_ELEMS = SLOT_BYTES / 2;
constexpr size_t W_IN = 0, W_POOL = 16 * MiB, W_BR = W_POOL + MiB / 2, W_OUT = W_BR + 6 * MiB, W_GU = W_OUT + 2 * MiB, W_DOWN = W_GU + 11 * MiB;
constexpr size_t SLOT0 = 42 * MiB;
static_assert(W_DOWN + (size_t)DM * DFF * 2 <= SLOT0, "weight map");
constexpr size_t WS_NEED = SLOT0 + 7 * SLOT_BYTES;
constexpr int LDS_BYTES = 139264;

typedef __bf16 bf16v2_t __attribute__((ext_vector_type(2)));
typedef float f32v2_t __attribute__((ext_vector_type(2)));
__device__ __forceinline__ unsigned cvt_pk_bf16(float lo, float hi) { const f32v2_t f = {lo, hi}; const bf16v2_t v = __builtin_convertvector(f, bf16v2_t); return __builtin_bit_cast(unsigned, v); }
__device__ __forceinline__ float bf_lo(unsigned u) { return __uint_as_float(u << 16); }
__device__ __forceinline__ float bf_hi(unsigned u) { return __uint_as_float(u & 0xffff0000u); }
__device__ __forceinline__ float fast_sigmoid(float x) { return __builtin_amdgcn_rcpf(1.0f + __expf(-x)); }
__device__ __forceinline__ float wave_sum(float v) {
#pragma unroll
    for (int o = 1; o < 64; o <<= 1) v += __shfl_xor(v, o);
    return v;
}

namespace pg8 {
constexpr int BM = 256, BK = 64, HALF = 128, HTB = HALF * BK * 2, STAGE_BYTES = 8 * HTB, NXCD = 8, WGM = 8;
__host__ __device__ __forceinline__ int lds_byte(int r, int c) { const int st = (r >> 4) * 2 + (c >> 5), rr = r & 15, cc = c & 31, ob = rr * 64 + cc * 2; return st * 1024 + (ob ^ (((ob >> 9) & 1) << 5)); }
__host__ __device__ __forceinline__ void stage_rc(int b, int& R, int& C) { const int st = b / 1024, sb = b % 1024, swz = sb ^ (((sb >> 9) & 1) << 5); R = (st >> 1) * 16 + swz / 64; C = (st & 1) * 32 + (swz % 64) / 2; }
__host__ __device__ __forceinline__ int perm32(int rho) { const int n = rho >> 4, i = rho & 15; return 8 * (i >> 2) + 4 * n + (i & 3); }

struct Unit { int pm, pn, z; };
template <int M_, int N_, int K_, int LDA_, int LDB_, int NZ_ = 1, int APN_ = 0, long AZ_ = 0, long BZ_ = 0>
struct Cfg { static constexpr int nM = M_ / BM, nN = N_ / BM, nwg = nM * nN, K = K_, LDA = LDA_, LDB = LDB_, NZ = NZ_, APN = APN_; static constexpr long AZ = AZ_, BZ = BZ_; };
template <class C>
__device__ __forceinline__ bool next_unit(int i, int G, int c, Unit& u) {
    const int round = i / C::NZ; u.z = i - round * C::NZ;
    const int L = round * G + c; if (L >= C::nwg) return false;
    int wgid = L; { constexpr int q = C::nwg / NXCD, r = C::nwg % NXCD; const int xcd = wgid % NXCD, off = wgid / NXCD; wgid = (xcd < r ? xcd * (q + 1) : r * (q + 1) + (xcd - r) * q) + off; }
    constexpr int nig = WGM * C::nN; const int gid = wgid / nig, fm = gid * WGM, gsz = (C::nM - fm) < WGM ? (C::nM - fm) : WGM;
    u.pm = fm + ((wgid % nig) % gsz); u.pn = (wgid % nig) / gsz; return true;
}

template <class C, class Epi>
__device__ __forceinline__ void gemm_phase(LAS unsigned char* lds, const bf16_t* gA, const bf16_t* gBt, const int G, const int c, const Epi& E) {
    int tid = threadIdx.x; asm volatile("" : "+v"(tid));
    const int wid = __builtin_amdgcn_readfirstlane(tid >> 6), lane = tid & 63, wr = wid >> 2, wc = wid & 3, fr = lane & 15, fq = lane >> 4;
    constexpr int nt = C::K / BK;
    unsigned voffA[2], voffB[2];
#pragma unroll
    for (int i = 0; i < 2; ++i) { int R, Cc; stage_rc(tid * 16 + i * 8192, R, Cc); const int Rb = Epi::PERM ? ((R & ~31) + perm32(R & 31)) : R;
        voffA[i] = (unsigned)(R * C::LDA + Cc) * 2u; voffB[i] = (unsigned)(Rb * C::LDB + Cc) * 2u; }
    constexpr unsigned kstep = BK * 2;
    constexpr unsigned hstepA = HALF * C::LDA * 2, hstepB = HALF * C::LDB * 2;
    const unsigned ldsw = (unsigned)wid * 1024u;
    const int aoff = lds_byte(wr * 64 + fr, fq * 8), boff = lds_byte(wc * 32 + fr, fq * 8);
#define PG8_APTR(u) ((const char*)gA + ((size_t)(u).z * C::AZ + (size_t)(u).pm * (BM * C::LDA) + (size_t)(u).pn * C::APN) * 2)
#define PG8_BPTR(u) ((const char*)gBt + ((size_t)(u).z * C::BZ + (size_t)(u).pn * (BM * C::LDB)) * 2)
#define PG8_SA(b, h) (((b) * 2 + (h)) * HTB)
#define PG8_SB(b, h) ((4 + (b) * 2 + (h)) * HTB)
#define PG8_STAGE(bufoff, gbase, voff) do { _Pragma("unroll") for (int _i = 0; _i < 2; ++_i) \
        __builtin_amdgcn_global_load_lds((const unsigned*)((const char*)(gbase) + (voff)[_i]), (LAS unsigned*)(lds + (bufoff) + ldsw + _i * 8192), 16, 0, 0); } while (0)
#define PG8_LDA(dst, b, h) do { _Pragma("unroll") for (int m = 0; m < 4; ++m) _Pragma("unroll") for (int k = 0; k < 2; ++k) dst[m][k] = *(const LAS bf16x8*)(lds + PG8_SA(b, h) + aoff + m * 2048 + k * 1024); } while (0)
#define PG8_LDB(dst, b, h) do { _Pragma("unroll") for (int n = 0; n < 2; ++n) _Pragma("unroll") for (int k = 0; k < 2; ++k) dst[n][k] = *(const LAS bf16x8*)(lds + PG8_SB(b, h) + boff + n * 2048 + k * 1024); } while (0)
#define PG8_MMA(ai, bj, At, Bt) do { __builtin_amdgcn_s_setprio(1); _Pragma("unroll") for (int m = 0; m < 4; ++m) _Pragma("unroll") for (int n = 0; n < 2; ++n) _Pragma("unroll") for (int k = 0; k < 2; ++k) \
        acc[ai][bj][m][n] = __builtin_amdgcn_mfma_f32_16x16x32_bf16(Bt[n][k], At[m][k], acc[ai][bj][m][n], 0, 0, 0); __builtin_amdgcn_s_setprio(0); } while (0)
#define PG8_WAIT_V(n) asm volatile("s_waitcnt vmcnt(" #n ")" ::: "memory")
#define PG8_WAIT_L(n) asm volatile("s_waitcnt lgkmcnt(" #n ")" ::: "memory")
#define PG8_BAR __builtin_amdgcn_s_barrier()
#define PG8_SCHED __builtin_amdgcn_sched_barrier(0)
    Unit cur, nxt; int ui = 0;
    if (!next_unit<C>(0, G, c, cur)) return;
    f32x4 acc[2][2][4][2];
#pragma unroll
    for (int a = 0; a < 2; ++a)
#pragma unroll
        for (int b = 0; b < 2; ++b)
#pragma unroll
            for (int m = 0; m < 4; ++m)
#pragma unroll
                for (int n = 0; n < 2; ++n) acc[a][b][m][n] = (f32x4){0.f, 0.f, 0.f, 0.f};
    bf16x8 At[4][2], B0[2][2], B1[2][2];
    const char* cA = PG8_APTR(cur); const char* cB = PG8_BPTR(cur);
    PG8_STAGE(PG8_SB(0, 0), cB, voffB); PG8_STAGE(PG8_SB(0, 1), cB + hstepB, voffB); PG8_STAGE(PG8_SA(0, 0), cA, voffA); PG8_STAGE(PG8_SA(0, 1), cA + hstepA, voffA);
    if (wr == 1) PG8_BAR;
    PG8_WAIT_V(2); PG8_BAR;
    PG8_STAGE(PG8_SB(1, 0), cB + kstep, voffB); PG8_STAGE(PG8_SA(1, 0), cA + kstep, voffA); PG8_STAGE(PG8_SB(1, 1), cB + hstepB + kstep, voffB);
    PG8_WAIT_V(6); PG8_BAR;
    for (;;) {
        const bool has_next = next_unit<C>(ui + 1, G, c, nxt);
        const char* nA = has_next ? PG8_APTR(nxt) : cA; const char* nB = has_next ? PG8_BPTR(nxt) : cB;
#pragma nounroll
        for (int t = 0; t < nt; t += 2) {
            const bool last = (t == nt - 2);
            const char* a1 = cA + (t + 1) * kstep;
            const char* a2 = last ? nA : cA + (t + 2) * kstep; const char* b2 = last ? nB : cB + (t + 2) * kstep;
            const char* a3 = a2 + kstep; const char* b3 = b2 + kstep;
            PG8_LDB(B0, 0, 0); PG8_LDB(B1, 0, 1); PG8_SCHED; PG8_LDA(At, 0, 0); PG8_STAGE(PG8_SA(1, 1), a1 + hstepA, voffA);
            PG8_WAIT_V(8); PG8_WAIT_L(0); PG8_BAR; PG8_MMA(0, 0, At, B0); PG8_MMA(0, 1, At, B1); PG8_BAR; PG8_SCHED;
            PG8_LDA(At, 0, 1); PG8_STAGE(PG8_SB(0, 0), b2, voffB); PG8_STAGE(PG8_SB(0, 1), b2 + hstepB, voffB); PG8_STAGE(PG8_SA(0, 0), a2, voffA);
            PG8_WAIT_V(8); PG8_WAIT_L(0); PG8_BAR; PG8_MMA(1, 0, At, B0); PG8_MMA(1, 1, At, B1); PG8_BAR; PG8_SCHED;
            PG8_LDB(B0, 1, 0); PG8_LDB(B1, 1, 1); PG8_SCHED; PG8_LDA(At, 1, 0); PG8_STAGE(PG8_SA(0, 1), a2 + hstepA, voffA);
            PG8_WAIT_V(8); PG8_WAIT_L(0); PG8_BAR; PG8_MMA(0, 0, At, B0); PG8_MMA(0, 1, At, B1); PG8_BAR; PG8_SCHED;
            PG8_LDA(At, 1, 1); PG8_STAGE(PG8_SB(1, 0), b3, voffB); PG8_STAGE(PG8_SB(1, 1), b3 + hstepB, voffB); PG8_STAGE(PG8_SA(1, 0), a3, voffA);
            PG8_WAIT_V(8); PG8_WAIT_L(0); PG8_BAR; PG8_MMA(1, 0, At, B0); PG8_MMA(1, 1, At, B1); PG8_BAR; PG8_SCHED;
        }
        if (wr == 0) PG8_BAR;
        E(acc, cur, wr, wc, fr, fq);
        if (!has_next) break;
#pragma unroll
        for (int a = 0; a < 2; ++a)
#pragma unroll
            for (int b = 0; b < 2; ++b)
#pragma unroll
                for (int m = 0; m < 4; ++m)
#pragma unroll
                    for (int n = 0; n < 2; ++n) acc[a][b][m][n] = (f32x4){0.f, 0.f, 0.f, 0.f};
        cur = nxt; cA = nA; cB = nB; ++ui;
        if (wr == 1) PG8_BAR;
    }
    PG8_WAIT_V(0);
    PG8_BAR;
#undef PG8_APTR
#undef PG8_BPTR
#undef PG8_SA
#undef PG8_SB
#undef PG8_STAGE
#undef PG8_LDA
#undef PG8_LDB
#undef PG8_MMA
#undef PG8_WAIT_V
#undef PG8_WAIT_L
#undef PG8_BAR
#undef PG8_SCHED
}

typedef f32x4 Acc[2][2][4][2];

struct EpiInProj {
    static constexpr bool PERM = true;
    bf16_t* base; bf16_t* vT;
    __device__ __forceinline__ void operator()(const Acc& acc, const Unit& u, int wr, int wc, int fr, int fq) const {
        const int row0 = u.pm * BM + wr * 64 + fr;
        if (u.pn < 16) {
            bf16_t* dst = base + (size_t)(u.pn >> 2) * SLOT_ELEMS; const int col0 = (u.pn & 3) * 256 + wc * 32 + 8 * fq;
#pragma unroll
            for (int ai = 0; ai < 2; ++ai)
#pragma unroll
                for (int m = 0; m < 4; ++m) { bf16_t* rowp = dst + (size_t)(row0 + ai * HALF + m * 16) * DM + col0;
#pragma unroll
                    for (int bj = 0; bj < 2; ++bj) { const f32x4 v0 = acc[ai][bj][m][0], v1 = acc[ai][bj][m][1]; u32x4 w;
                        w.x = cvt_pk_bf16(v0[0], v0[1]); w.y = cvt_pk_bf16(v0[2], v0[3]); w.z = cvt_pk_bf16(v1[0], v1[1]); w.w = cvt_pk_bf16(v1[2], v1[3]);
                        *(u32x4*)(rowp + bj * HALF) = w; } }
        } else {
#pragma unroll
            for (int ai = 0; ai < 2; ++ai)
#pragma unroll
                for (int m = 0; m < 4; ++m) { const int row = row0 + ai * HALF + m * 16; const int b = row >> 11, s = row & 2047;
#pragma unroll
                    for (int bj = 0; bj < 2; ++bj) { const int head = (u.pn - 16) * 2 + bj;
                        bf16_t* p = vT + ((size_t)((b * NH + head) * HD + wc * 32 + 8 * fq)) * SEQ + s;
#pragma unroll
                        for (int n = 0; n < 2; ++n) { const f32x4 v = acc[ai][bj][m][n];
                            const unsigned w0 = cvt_pk_bf16(v[0], v[1]), w1 = cvt_pk_bf16(v[2], v[3]);
                            p[(size_t)(4 * n + 0) * SEQ] = (bf16_t)(w0 & 0xffffu); p[(size_t)(4 * n + 1) * SEQ] = (bf16_t)(w0 >> 16);
                            p[(size_t)(4 * n + 2) * SEQ] = (bf16_t)(w1 & 0xffffu); p[(size_t)(4 * n + 3) * SEQ] = (bf16_t)(w1 >> 16); } } }
        }
    }
};
template <int MODE> struct EpiColOp {
    static constexpr bool PERM = true;
    bf16_t* O; int ldc; const float* vec;
    __device__ __forceinline__ void operator()(const Acc& acc, const Unit& u, int wr, int wc, int fr, int fq) const {
        const int row0 = u.pm * BM + wr * 64 + fr, col0 = u.pn * BM + wc * 32 + 8 * fq;
        f32x4 bv[2][2];
#pragma unroll
        for (int bj = 0; bj < 2; ++bj)
#pragma unroll
            for (int n = 0; n < 2; ++n) bv[bj][n] = *(const f32x4*)(vec + col0 + bj * HALF + 4 * n);
#pragma unroll
        for (int ai = 0; ai < 2; ++ai)
#pragma unroll
            for (int m = 0; m < 4; ++m) { bf16_t* rowp = O + (size_t)(row0 + ai * HALF + m * 16) * ldc + col0;
#pragma unroll
                for (int bj = 0; bj < 2; ++bj) { f32x4 v0 = acc[ai][bj][m][0], v1 = acc[ai][bj][m][1];
                    if (MODE == 0) { v0 = v0 + bv[bj][0]; v1 = v1 + bv[bj][1];
#pragma unroll
                        for (int j = 0; j < 4; ++j) { v0[j] = fast_sigmoid(v0[j]); v1[j] = fast_sigmoid(v1[j]); } }
                    else { v0 = v0 * bv[bj][0]; v1 = v1 * bv[bj][1]; }
                    u32x4 w; w.x = cvt_pk_bf16(v0[0], v0[1]); w.y = cvt_pk_bf16(v0[2], v0[3]); w.z = cvt_pk_bf16(v1[0], v1[1]); w.w = cvt_pk_bf16(v1[2], v1[3]);
                    *(u32x4*)(rowp + bj * HALF) = w; } }
    }
};
struct EpiMerge {
    static constexpr bool PERM = true;
    const bf16_t* gates; bf16_t* merged;
    __device__ __forceinline__ void operator()(const Acc& acc, const Unit& u, int wr, int wc, int fr, int fq) const {
        const int row0 = u.pm * BM + wr * 64 + fr, col0 = u.pn * BM + wc * 32 + 8 * fq;
#pragma unroll
        for (int ai = 0; ai < 2; ++ai)
#pragma unroll
            for (int m = 0; m < 4; ++m) { const size_t row = (size_t)(row0 + ai * HALF + m * 16);
#pragma unroll
                for (int bj = 0; bj < 2; ++bj) { const int col = col0 + bj * HALF;
                    const u32x4 gv = *(const u32x4*)(gates + row * (3 * DM) + u.z * DM + col);
                    u32x4 pv = (u32x4){0u, 0u, 0u, 0u}; if (u.z > 0) pv = *(const u32x4*)(merged + row * DM + col);
                    const f32x4 v0 = acc[ai][bj][m][0], v1 = acc[ai][bj][m][1]; u32x4 w;
                    w.x = cvt_pk_bf16(bf_lo(pv.x) + bf_lo(gv.x) * v0[0], bf_hi(pv.x) + bf_hi(gv.x) * v0[1]);
                    w.y = cvt_pk_bf16(bf_lo(pv.y) + bf_lo(gv.y) * v0[2], bf_hi(pv.y) + bf_hi(gv.y) * v0[3]);
                    w.z = cvt_pk_bf16(bf_lo(pv.z) + bf_lo(gv.z) * v1[0], bf_hi(pv.z) + bf_hi(gv.z) * v1[1]);
                    w.w = cvt_pk_bf16(bf_lo(pv.w) + bf_lo(gv.w) * v1[2], bf_hi(pv.w) + bf_hi(gv.w) * v1[3]);
                    *(u32x4*)(merged + row * DM + col) = w; } }
    }
};
struct EpiResid {
    static constexpr bool PERM = false;
    const float* base; float* out;
    __device__ __forceinline__ void operator()(const Acc& acc, const Unit& u, int wr, int wc, int fr, int fq) const {
        const int row0 = u.pm * BM + wr * 64 + fr, col0 = u.pn * BM + wc * 32 + 4 * fq;
#pragma unroll
        for (int ai = 0; ai < 2; ++ai)
#pragma unroll
            for (int m = 0; m < 4; ++m) { const size_t off = (size_t)(row0 + ai * HALF + m * 16) * DM + col0;
#pragma unroll
                for (int bj = 0; bj < 2; ++bj)
#pragma unroll
                    for (int n = 0; n < 2; ++n) { const f32x4 bs = *(const f32x4*)(base + off + bj * HALF + n * 16);
                        *(f32x4*)(out + off + bj * HALF + n * 16) = bs + acc[ai][bj][m][n]; } }
    }
};
struct EpiSwiglu {
    static constexpr bool PERM = false;
    bf16_t* act;
    __device__ __forceinline__ void operator()(const Acc& acc, const Unit& u, int wr, int wc, int fr, int fq) const {
        const int row0 = u.pm * BM + wr * 64 + fr, col0 = u.pn * 128 + wc * 16 + 4 * fq;
#pragma unroll
        for (int ai = 0; ai < 2; ++ai)
#pragma unroll
            for (int m = 0; m < 4; ++m) { bf16_t* rowp = act + (size_t)(row0 + ai * HALF + m * 16) * DFF + col0;
#pragma unroll
                for (int bj = 0; bj < 2; ++bj) { const f32x4 gt = acc[ai][bj][m][0], up = acc[ai][bj][m][1]; f32x4 r;
#pragma unroll
                    for (int j = 0; j < 4; ++j) r[j] = gt[j] * fast_sigmoid(gt[j]) * up[j];
                    u32x2 w; w.x = cvt_pk_bf16(r[0], r[1]); w.y = cvt_pk_bf16(r[2], r[3]);
                    *(u32x2*)(rowp + bj * 64) = w; } }
    }
};
}

__device__ __forceinline__ void transpose_item(const float* W, int K, int N, bf16_t* WT, int row_off, int mode, LAS float* scr, int item, int lane) {
    const int nblk = N / 32, kb = item / nblk, nb = item % nblk, k0 = 64 * kb, n0 = 32 * nb;
#pragma unroll 8
    for (int i = 0; i < 32; ++i) { const int kk = 2 * i + (lane >> 5); scr[kk * 33 + (lane & 31)] = W[(size_t)(k0 + kk) * N + n0 + (lane & 31)]; }
    asm volatile("s_waitcnt lgkmcnt(0)" ::: "memory");
    const int c = lane & 7;
#pragma unroll
    for (int j = 0; j < 4; ++j) { const int n = (lane >> 3) + 8 * j; const LAS float* s = scr + (8 * c) * 33 + n;
        u32x4 o; o.x = cvt_pk_bf16(s[0 * 33], s[1 * 33]); o.y = cvt_pk_bf16(s[2 * 33], s[3 * 33]); o.z = cvt_pk_bf16(s[4 * 33], s[5 * 33]); o.w = cvt_pk_bf16(s[6 * 33], s[7 * 33]);
        const int ng = n0 + n; const int drow = (mode == 0) ? (row_off + ng) : (32 * (ng >> 4) + (ng & 15) + 16 * (mode - 1));
        *(u32x4*)(WT + (size_t)drow * K + k0 + 8 * c) = o; }
    asm volatile("s_waitcnt lgkmcnt(0)" ::: "memory");
}

struct Params { const float* in[21]; float* out; unsigned char* ws; int lo, hi, dbg, pad; };

__device__ __forceinline__ void convert_weights(const Params& P, int l, LAS unsigned char* lds, int gw, int NGW, int wave, int lane) {
    LAS float* scr = (LAS float*)(lds + wave * 16384);
    unsigned char* ws = P.ws;
    constexpr int I_IN = 16 * 256, I_POOL = 4 * 8, I_BR = 16 * 32, I_OUT = 16 * 32, I_G = 16 * 88, I_D = 44 * 32;
    constexpr int NITEMS = I_IN + 4 * I_POOL + 3 * I_BR + I_OUT + 2 * I_G + I_D;
    for (int it = gw; it < NITEMS; it += NGW) {
        int r = it;
        if (r < I_IN) { transpose_item(P.in[2] + (size_t)l * DM * 8192, DM, 8192, (bf16_t*)(ws + W_IN), 0, 0, scr, r, lane); continue; } r -= I_IN;
        if (r < 4 * I_POOL) { const int g = r / I_POOL; transpose_item(P.in[4] + (size_t)(l * 4 + g) * 65536, 256, 256, (bf16_t*)(ws + W_POOL), g * 256, 0, scr, r % I_POOL, lane); continue; } r -= 4 * I_POOL;
        if (r < 3 * I_BR) { const int b = r / I_BR; transpose_item(P.in[15] + (size_t)(l * 3 + b) * DM * DM, DM, DM, (bf16_t*)(ws + W_BR) + (size_t)b * DM * DM, 0, 0, scr, r % I_BR, lane); continue; } r -= 3 * I_BR;
        if (r < I_OUT) { transpose_item(P.in[16] + (size_t)l * DM * DM, DM, DM, (bf16_t*)(ws + W_OUT), 0, 0, scr, r, lane); continue; } r -= I_OUT;
        if (r < I_G) { transpose_item(P.in[18] + (size_t)l * DM * DFF, DM, DFF, (bf16_t*)(ws + W_GU), 0, 1, scr, r, lane); continue; } r -= I_G;
        if (r < I_G) { transpose_item(P.in[19] + (size_t)l * DM * DFF, DM, DFF, (bf16_t*)(ws + W_GU), 0, 2, scr, r, lane); continue; } r -= I_G;
        transpose_item(P.in[20] + (size_t)l * DFF * DM, DFF, DM, (bf16_t*)(ws + W_DOWN), 0, 0, scr, r, lane);
    }
}

__device__ __forceinline__ void rms_rows(const float* x, const float* g, bf16_t* out, int gw, int NGW, int lane) {
    for (int m = gw; m < MTOK; m += NGW) {
        const f32x4* xr = (const f32x4*)(x + (size_t)m * DM) + lane; f32x4 v[4]; float s = 0.f;
#pragma unroll
        for (int j = 0; j < 4; ++j) { v[j] = xr[64 * j]; s += (v[j][0] * v[j][0] + v[j][1] * v[j][1]) + (v[j][2] * v[j][2] + v[j][3] * v[j][3]); }
        const float rstd = rsqrtf(wave_sum(s) * (1.f / DM) + EPS);
        u32x2* o = (u32x2*)(out + (size_t)m * DM) + lane;
#pragma unroll
        for (int j = 0; j < 4; ++j) { const f32x4 gg = ((const f32x4*)g)[64 * j + lane]; u32x2 w;
            w.x = cvt_pk_bf16(v[j][0] * rstd * gg[0], v[j][1] * rstd * gg[1]); w.y = cvt_pk_bf16(v[j][2] * rstd * gg[2], v[j][3] * rstd * gg[3]); o[64 * j] = w; }
    }
}

__device__ __forceinline__ void qk_norm_rows(bf16_t* q, bf16_t* k, const float* qg, const float* kg, int gw, int NGW, int lane) {
    const int d0 = (lane & 7) * 16;
    for (int it = gw; it < 2 * MTOK; it += NGW) {
        const int which = it >= MTOK; const int m = it - which * MTOK;
        bf16_t* p = (which ? k : q) + (size_t)m * DM + lane * 16; const float* gg = (which ? kg : qg) + d0;
        const u32x4 a = *(const u32x4*)p, b = *(const u32x4*)(p + 8);
        float v[16];
        v[0] = bf_lo(a.x); v[1] = bf_hi(a.x); v[2] = bf_lo(a.y); v[3] = bf_hi(a.y); v[4] = bf_lo(a.z); v[5] = bf_hi(a.z); v[6] = bf_lo(a.w); v[7] = bf_hi(a.w);
        v[8] = bf_lo(b.x); v[9] = bf_hi(b.x); v[10] = bf_lo(b.y); v[11] = bf_hi(b.y); v[12] = bf_lo(b.z); v[13] = bf_hi(b.z); v[14] = bf_lo(b.w); v[15] = bf_hi(b.w);
        float ss = 0.f;
#pragma unroll
        for (int e = 0; e < 16; ++e) ss += v[e] * v[e];
        ss += __shfl_xor(ss, 1); ss += __shfl_xor(ss, 2); ss += __shfl_xor(ss, 4);
        const float rstd = rsqrtf(ss * (1.f / HD) + EPS);
        unsigned w[8];
#pragma unroll
        for (int e = 0; e < 8; ++e) w[e] = cvt_pk_bf16(v[2 * e] * rstd * gg[2 * e], v[2 * e + 1] * rstd * gg[2 * e + 1]);
        *(u32x4*)p = (u32x4){w[0], w[1], w[2], w[3]}; *(u32x4*)(p + 8) = (u32x4){w[4], w[5], w[6], w[7]};
    }
}

__device__ __forceinline__ void unpack8(const u32x4 a, float (&v)[8]) { v[0] = bf_lo(a.x); v[1] = bf_hi(a.x); v[2] = bf_lo(a.y); v[3] = bf_hi(a.y); v[4] = bf_lo(a.z); v[5] = bf_hi(a.z); v[6] = bf_lo(a.w); v[7] = bf_hi(a.w); }
__device__ __forceinline__ void pool_elem(const bf16_t* u, bf16_t* p, int gtid, int NT) {
    for (int id = gtid; id < BATCH * 128 * 128; id += NT) {
        const int oct = id & 127, strip = (id >> 7) & 127, b = id >> 14;
        const int c0 = oct * 8, w = 2 << (c0 >> 8), t0 = strip * 16;
        const bf16_t* ub = u + (size_t)b * SEQ * DM + c0; bf16_t* pb = p + (size_t)b * SEQ * DM + c0;
        float S[8];
#pragma unroll
        for (int e = 0; e < 8; ++e) S[e] = 0.f;
        for (int k = 1; k <= w; ++k) { const int t = t0 - k; if (t >= 0) { float v[8]; unpack8(*(const u32x4*)(ub + (size_t)t * DM), v);
#pragma unroll
                for (int e = 0; e < 8; ++e) S[e] += v[e]; } }
        for (int i = 0; i < 16; ++i) { const int t = t0 + i; float v[8]; unpack8(*(const u32x4*)(ub + (size_t)t * DM), v);
            if (t - w >= 0) { float o[8]; unpack8(*(const u32x4*)(ub + (size_t)(t - w) * DM), o);
#pragma unroll
                for (int e = 0; e < 8; ++e) S[e] -= o[e]; }
            const float inv = 1.f / (float)((t + 1) < w ? (t + 1) : w); float r[8];
#pragma unroll
            for (int e = 0; e < 8; ++e) { S[e] += v[e]; r[e] = S[e] * inv - v[e]; }
            *(u32x4*)(pb + (size_t)t * DM) = (u32x4){cvt_pk_bf16(r[0], r[1]), cvt_pk_bf16(r[2], r[3]), cvt_pk_bf16(r[4], r[5]), cvt_pk_bf16(r[6], r[7])}; }
    }
}

__device__ __forceinline__ void lru_phase(const Params& P, int l, LAS unsigned char* lds, bf16_t* ulru, int G, int c) {
    int tid = threadIdx.x; asm volatile("" : "+v"(tid));
    const int lane = tid & 63, wave = tid >> 6;
    LAS float* U = (LAS float*)lds;
    LAS float* XC = (LAS float*)(lds + 33536);
    LAS float* AL = (LAS float*)(lds + 33536 + 32768);
    LAS bf16_t* XCB = (LAS bf16_t*)(lds + 33536 + 65536);
    LAS float* GA = (LAS float*)(lds + 33536 + 65536 + 18432);
    LAS float* GH = GA + 512;
    const float* conv_w = P.in[6] + (size_t)l * 4 * DM; const float* conv_b = P.in[7] + (size_t)l * DM;
    const float* w_rg = P.in[8] + (size_t)l * 16 * 4096; const float* b_rg = P.in[9] + (size_t)l * DM;
    const float* w_ig = P.in[10] + (size_t)l * 16 * 4096; const float* b_ig = P.in[11] + (size_t)l * DM;
    const float* lam = P.in[12] + (size_t)l * DM;
    for (int it = c; it < BATCH * 16; it += G) {
        const int b = it >> 4, hb = it & 15, ch0 = hb * 64;
        const int chl = ch0 + lane;
        const float cw0 = conv_w[chl], cw1 = conv_w[DM + chl], cw2 = conv_w[2 * DM + chl], cw3 = conv_w[3 * DM + chl], cb = conv_b[chl];
        float brg[4], big[4], sp8[4];
#pragma unroll
        for (int nt = 0; nt < 4; ++nt) { const int ch = ch0 + 16 * nt + (lane & 15); brg[nt] = b_rg[ch]; big[nt] = b_ig[ch];
            const float x = -lam[ch]; sp8[nt] = -8.0f * (fmaxf(x, 0.f) + log1pf(__expf(-fabsf(x)))); }
        bf16x8 wf[8][2];
#pragma unroll
        for (int nt = 0; nt < 8; ++nt)
#pragma unroll
            for (int ks = 0; ks < 2; ++ks) { const float* wsrc = (nt < 4 ? w_rg : w_ig) + (size_t)hb * 4096 + 16 * (nt & 3) + (lane & 15);
                const int k0 = ks * 32 + (lane >> 4) * 8; unsigned pk[4];
#pragma unroll
                for (int e = 0; e < 4; ++e) pk[e] = cvt_pk_bf16(wsrc[(k0 + 2 * e) * 64], wsrc[(k0 + 2 * e + 1) * 64]);
                u32x4 t4 = (u32x4){pk[0], pk[1], pk[2], pk[3]}; asm volatile("" : "+v"(t4) :: "memory");
                wf[nt][ks] = __builtin_bit_cast(bf16x8, t4); }
        float carry = 0.f;
        __syncthreads();
        if (tid < 192) U[tid] = 0.f;
        bf16_t* ubase = ulru + (size_t)b * SEQ * DM + ch0;
        for (int ck = 0; ck < SEQ / 128; ++ck) {
            const int t0 = ck * 128;
#pragma unroll
            for (int ps = 0; ps < 2; ++ps) { const int r = ps * 64 + (tid >> 3), part = tid & 7; float v[8];
                unpack8(*(const u32x4*)(ubase + (size_t)(t0 + r) * DM + part * 8), v);
#pragma unroll
                for (int e = 0; e < 8; ++e) U[(3 + r) * 64 + part * 8 + e] = v[e]; }
            __syncthreads();
#pragma unroll 4
            for (int i = 0; i < 16; ++i) { const int t = wave * 16 + i;
                const float xc = cb + cw0 * U[t * 64 + lane] + cw1 * U[(t + 1) * 64 + lane] + cw2 * U[(t + 2) * 64 + lane] + cw3 * U[(t + 3) * 64 + lane];
                XC[t * 64 + lane] = xc; XCB[t * 72 + lane] = (bf16_t)(cvt_pk_bf16(xc, 0.f) & 0xffffu); }
            __syncthreads();
            if (tid < 192) U[tid] = U[128 * 64 + tid];
            {
                f32x4 ga[8];
                { float zf = 0.f; asm volatile("" : "+v"(zf));
#pragma unroll
                  for (int nt = 0; nt < 8; ++nt) ga[nt] = (f32x4){zf, zf, zf, zf}; }
#pragma unroll
                for (int ks = 0; ks < 2; ++ks) { const bf16x8 af = *(const LAS bf16x8*)(XCB + (wave * 16 + (lane & 15)) * 72 + ks * 32 + (lane >> 4) * 8);
#pragma unroll
                    for (int nt = 0; nt < 8; ++nt) ga[nt] = __builtin_amdgcn_mfma_f32_16x16x32_bf16(af, wf[nt][ks], ga[nt], 0, 0, 0); }
#pragma unroll
                for (int nt = 0; nt < 4; ++nt)
#pragma unroll
                    for (int j = 0; j < 4; ++j) { const int t = wave * 16 + 4 * (lane >> 4) + j, ch = 16 * nt + (lane & 15);
                        const float r = fast_sigmoid(ga[nt][j] + brg[nt]), ig = fast_sigmoid(ga[nt + 4][j] + big[nt]);
                        const float log_a = r * sp8[nt]; const float a = __expf(log_a); const float mult = sqrtf(fmaxf(-expm1f(2.0f * log_a), 0.f));
                        const float xc = XC[t * 64 + ch];
                        AL[t * 64 + ch] = a; XC[t * 64 + ch] = mult * (ig * xc); }
            }
            __syncthreads();
            { float Ap = 1.f, Hp = 0.f;
#pragma unroll 4
                for (int i = 0; i < 16; ++i) { const int t = wave * 16 + i; const float a = AL[t * 64 + lane], bb = XC[t * 64 + lane];
                    Hp = a * Hp + bb; Ap *= a; XC[t * 64 + lane] = Hp; AL[t * 64 + lane] = Ap; }
                GA[wave * 64 + lane] = Ap; GH[wave * 64 + lane] = Hp; }
            __syncthreads();
            { float hin = carry, hall = carry;
#pragma unroll
                for (int g2 = 0; g2 < 8; ++g2) { const float ga2 = GA[g2 * 64 + lane], gh2 = GH[g2 * 64 + lane]; hall = ga2 * hall + gh2; if (g2 < wave) hin = hall; }
                carry = hall;
#pragma unroll 4
                for (int i = 0; i < 16; ++i) { const int t = wave * 16 + i; const float h = XC[t * 64 + lane] + AL[t * 64 + lane] * hin;
                    ubase[(size_t)(t0 + t) * DM + lane] = (bf16_t)(cvt_pk_bf16(h, 0.f) & 0xffffu); } }
            __syncthreads();
        }
    }
}

__device__ __forceinline__ void attn_phase(LAS unsigned char* lds, bf16_t* qn, const bf16_t* kn, const bf16_t* vT, int G, int c) {
    int tid = threadIdx.x; asm volatile("" : "+v"(tid));
    const int lane = tid & 63, w = __builtin_amdgcn_readfirstlane(tid >> 6), l31 = lane & 31, hi = lane >> 5;
    constexpr int KSTR = 272, VSTR = 136, KBYTES = 64 * KSTR, VBYTES = 128 * VSTR, BUF = KBYTES + VBYTES;
    constexpr int NITEM = BATCH * NH * 8;
    const float scale = 0.08838834764831845f;
    for (int i = 0;; ++i) {
        int b, h, qb;
        if (G == 256) { if (i >= 4) break; const int bh = c & 127, half = c >> 7; b = bh >> 3; h = bh & 7;
            qb = (i == 0) ? (7 - half) : (i == 1) ? half : (i == 2) ? (5 - half) : (2 + half); }
        else { const int L = i * G + c; if (L >= NITEM) break; qb = 7 - (L >> 7); const int bh = L & 127; b = bh >> 3; h = bh & 7; }
        const size_t tokbase = (size_t)b * SEQ;
        const int qmin = qb * 256 + 32 * w, qrow = qmin + l31, qmax = qmin + 31;
        bf16x8 qf[8];
        { const bf16_t* qp = qn + (tokbase + qrow) * DM + h * HD + hi * 8;
#pragma unroll
            for (int ks = 0; ks < 8; ++ks) qf[ks] = *(const bf16x8*)(qp + ks * 16); }
        f32x16 O[4];
#pragma unroll
        for (int db = 0; db < 4; ++db)
#pragma unroll
            for (int e = 0; e < 16; ++e) O[db][e] = 0.f;
        float R = 0.f;
        const int ntile = 4 * qb + 4;
        const bf16_t* kbase = kn + tokbase * DM + h * HD + (size_t)(tid >> 3) * DM + (tid & 7) * 16;
        const bf16_t* vbase = vT + ((size_t)((b * NH + h) * HD) + (tid >> 2)) * SEQ + (tid & 3) * 16;
        const int kst = (tid >> 3) * KSTR + (tid & 7) * 32, vst = KBYTES + (tid >> 2) * VSTR + (tid & 3) * 32;
        u32x4 kr0, kr1, vr0, vr1;
#define ATT_LOAD(kt) do { const bf16_t* kp_ = kbase + (size_t)(kt) * 64 * DM; kr0 = *(const u32x4*)kp_; kr1 = *(const u32x4*)(kp_ + 8); \
        const bf16_t* vp_ = vbase + (kt) * 64; vr0 = *(const u32x4*)vp_; vr1 = *(const u32x4*)(vp_ + 8); } while (0)
#define ATT_STORE(buf) do { LAS unsigned char* d_ = lds + (buf) * BUF; *(LAS u32x4*)(d_ + kst) = kr0; *(LAS u32x4*)(d_ + kst + 16) = kr1; \
        *(LAS u32x2*)(d_ + vst) = (u32x2){vr0.x, vr0.y}; *(LAS u32x2*)(d_ + vst + 8) = (u32x2){vr0.z, vr0.w}; \
        *(LAS u32x2*)(d_ + vst + 16) = (u32x2){vr1.x, vr1.y}; *(LAS u32x2*)(d_ + vst + 24) = (u32x2){vr1.z, vr1.w}; } while (0)
        __syncthreads();
        ATT_LOAD(ntile - 1); ATT_STORE(0);
        __syncthreads();
        int cur = 0;
        for (int kt = ntile - 1; kt >= 0; --kt) {
            if (kt > 0) ATT_LOAD(kt - 1);
            const int k0 = kt * 64;
            if (k0 < qmax) {
                const bool diag = (k0 + 63 >= qmin);
                const LAS unsigned char* Kt = lds + cur * BUF; const LAS unsigned char* Vt = Kt + KBYTES;
                float E = R;
#pragma unroll
                for (int kb = 1; kb >= 0; --kb) {
                    f32x16 s;
                    { float zf = 0.f; asm volatile("" : "+v"(zf));
#pragma unroll
                      for (int e = 0; e < 16; ++e) s[e] = zf; }
#pragma unroll
                    for (int ks = 0; ks < 8; ++ks) { const bf16x8 a = *(const LAS bf16x8*)(Kt + (32 * kb + l31) * KSTR + (ks * 16 + hi * 8) * 2);
                        s = __builtin_amdgcn_mfma_f32_32x32x16_bf16(a, qf[ks], s, 0, 0, 0); }
                    float ls[16], lk[16];
#pragma unroll
                    for (int e = 0; e < 16; ++e) { const float z = s[e] * scale; const float sp = __logf(1.0f + __expf(-fabsf(z)));
                        float lse = fminf(z, 0.f) - sp, lke = lse - z;
                        if (diag) { const int key = k0 + 32 * kb + 8 * (e >> 2) + 4 * hi + (e & 3); if (key >= qrow) { lke = 0.f; lse = -INFINITY; } }
                        ls[e] = lse; lk[e] = lke; }
                    float gs[4], gp[4];
#pragma unroll
                    for (int bb = 0; bb < 4; ++bb) { gs[bb] = (lk[4 * bb] + lk[4 * bb + 1]) + (lk[4 * bb + 2] + lk[4 * bb + 3]); gp[bb] = __shfl_xor(gs[bb], 32); }
                    float wv[16];
#pragma unroll
                    for (int bb = 3; bb >= 0; --bb) { float base = hi ? E : E + gp[bb];
                        wv[4 * bb + 3] = __expf(ls[4 * bb + 3] + base); base += lk[4 * bb + 3];
                        wv[4 * bb + 2] = __expf(ls[4 * bb + 2] + base); base += lk[4 * bb + 2];
                        wv[4 * bb + 1] = __expf(ls[4 * bb + 1] + base); base += lk[4 * bb + 1];
                        wv[4 * bb + 0] = __expf(ls[4 * bb + 0] + base);
                        E += gs[bb] + gp[bb]; }
#pragma unroll
                    for (int p = 0; p < 2; ++p) {
                        u32x4 pa4 = (u32x4){cvt_pk_bf16(wv[8 * p], wv[8 * p + 1]), cvt_pk_bf16(wv[8 * p + 2], wv[8 * p + 3]), cvt_pk_bf16(wv[8 * p + 4], wv[8 * p + 5]), cvt_pk_bf16(wv[8 * p + 6], wv[8 * p + 7])};
                        const bf16x8 pa = __builtin_bit_cast(bf16x8, pa4);
#pragma unroll
                        for (int db = 0; db < 4; ++db) { const LAS unsigned char* vp = Vt + (32 * db + l31) * VSTR + (32 * kb + 16 * p + 4 * hi) * 2;
                            const u32x2 v0 = *(const LAS u32x2*)vp, v1 = *(const LAS u32x2*)(vp + 16);
                            u32x4 vb4 = (u32x4){v0.x, v0.y, v1.x, v1.y};
                            O[db] = __builtin_amdgcn_mfma_f32_32x32x16_bf16(pa, __builtin_bit_cast(bf16x8, vb4), O[db], 0, 0, 0); }
                    }
                }
                R = E;
            }
            if (kt > 0) ATT_STORE(cur ^ 1);
            __syncthreads();
            cur ^= 1;
        }
#undef ATT_LOAD
#undef ATT_STORE
#pragma unroll
        for (int db = 0; db < 4; ++db)
#pragma unroll
            for (int e = 0; e < 16; ++e) { const int q = qmin + 8 * (e >> 2) + 4 * hi + (e & 3);
                (qn + DBG_OUT_OFF)[(tokbase + q) * DM + h * HD + 32 * db + l31] = (bf16_t)(cvt_pk_bf16(O[db][e], 0.f) & 0xffffu); }
    }
}

__global__ void __launch_bounds__(512, 2) mega(Params P) {
    extern __shared__ __attribute__((aligned(16))) unsigned char lds_raw[];
    LAS unsigned char* lds = (LAS unsigned char*)lds_raw;
    cg::grid_group grid = cg::this_grid();
    const int G = gridDim.x, c = blockIdx.x;
    unsigned char* ws = P.ws;
    bf16_t* s0 = (bf16_t*)(ws + SLOT0);
    bf16_t* s1 = s0 + SLOT_ELEMS; bf16_t* s2 = s1 + SLOT_ELEMS; bf16_t* s3 = s2 + SLOT_ELEMS; bf16_t* s4 = s3 + SLOT_ELEMS; bf16_t* s5 = s4 + SLOT_ELEMS; bf16_t* s6 = s5 + SLOT_ELEMS;
    const bf16_t* Win = (const bf16_t*)(ws + W_IN); const bf16_t* Wpool = (const bf16_t*)(ws + W_POOL); const bf16_t* Wbr = (const bf16_t*)(ws + W_BR);
    const bf16_t* Wout = (const bf16_t*)(ws + W_OUT); const bf16_t* Wgu = (const bf16_t*)(ws + W_GU); const bf16_t* Wdown = (const bf16_t*)(ws + W_DOWN);
    const int lo = P.lo, hi = P.hi;
#define IN(k) (lo <= (k) && (k) < hi)
#define SEAM(k) do { if (IN(k) && IN((k) + 1)) { asm volatile("s_waitcnt vmcnt(0) lgkmcnt(0)" ::: "memory"); grid.sync(); \
        __builtin_amdgcn_fence(__ATOMIC_ACQUIRE, "agent"); asm volatile("s_waitcnt vmcnt(0)" ::: "memory"); } } while (0)
    for (int l = 0; l < NLAYER; ++l) {
        const int pb = l * 10;
        int tid = threadIdx.x; asm volatile("" : "+v"(tid));
        const int lane = tid & 63, wave = __builtin_amdgcn_readfirstlane(tid >> 6);
        const int gw = c * 8 + wave, NGW = G * 8, gtid = c * 512 + tid, NT = G * 512;
        const float* xin = (l == 0) ? P.in[0] : P.out;
        if (IN(pb + 0)) {
            convert_weights(P, l, lds, gw, NGW, wave, lane);
            rms_rows(xin, P.in[1] + (size_t)l * DM, s0, gw, NGW, lane);
        }
        SEAM(pb + 0);
        if (IN(pb + 1)) {
            using C1 = pg8::Cfg<MTOK, 5120, DM, DM, DM>;
            pg8::EpiInProj E{s1, s5};
            pg8::gemm_phase<C1>(lds, s0, Win, G, c, E);
        }
        SEAM(pb + 1);
        if (IN(pb + 2)) {
            lru_phase(P, l, lds, s2, G, c);
            qk_norm_rows(s3, s4, P.in[13] + (size_t)l * HD, P.in[14] + (size_t)l * HD, gw, NGW, lane);
            pool_elem(s1, s6, gtid, NT);
        }
        SEAM(pb + 2);
        if (IN(pb + 3)) {
            { using C2 = pg8::Cfg<MTOK, DM, 256, DM, 256, 1, 256>;
              pg8::EpiColOp<1> E{s1, DM, P.in[5] + (size_t)l * DM};
#ifndef DBG_NOPOOLG
              pg8::gemm_phase<C2>(lds, s6, Wpool, G, c, E);
#endif
            }
            attn_phase(lds, s3, s4, s5, G, c);
        }
        SEAM(pb + 3);
        if (IN(pb + 4)) {
            using C3 = pg8::Cfg<MTOK, 3 * DM, DM, DM, DM>;
            pg8::EpiColOp<0> E{s4, 3 * DM, P.in[3] + (size_t)l * 3 * DM};
            pg8::gemm_phase<C3>(lds, s0, Win + (size_t)5120 * DM, G, c, E);
        }
        SEAM(pb + 4);
        if (IN(pb + 5)) {
            using C4 = pg8::Cfg<MTOK, DM, DM, DM, DM, 3, 0, (long)SLOT_ELEMS, (long)DM * DM>;
            pg8::EpiMerge E{s4, s0};
            pg8::gemm_phase<C4>(lds, s1, Wbr, G, c, E);
        }
        SEAM(pb + 5);
        if (IN(pb + 6)) {
            using C5 = pg8::Cfg<MTOK, DM, DM, DM, DM>;
            pg8::EpiResid E{xin, P.out};
            pg8::gemm_phase<C5>(lds, s0, Wout, G, c, E);
        }
        SEAM(pb + 6);
        if (IN(pb + 7)) rms_rows(P.out, P.in[17] + (size_t)l * DM, s0, gw, NGW, lane);
        SEAM(pb + 7);
        if (IN(pb + 8)) {
            using C6 = pg8::Cfg<MTOK, NGU, DM, DM, DM>;
            pg8::EpiSwiglu E{s3};
            pg8::gemm_phase<C6>(lds, s0, Wgu, G, c, E);
        }
        SEAM(pb + 8);
        if (IN(pb + 9)) {
            using C7 = pg8::Cfg<MTOK, DM, DFF, DFF, DFF>;
            pg8::EpiResid E{P.out, P.out};
            pg8::gemm_phase<C7>(lds, s3, Wdown, G, c, E);
        }
        SEAM(pb + 9);
    }
    if (P.dbg >= 0) {
        asm volatile("s_waitcnt vmcnt(0) lgkmcnt(0)" ::: "memory"); grid.sync(); __builtin_amdgcn_fence(__ATOMIC_ACQUIRE, "agent"); asm volatile("s_waitcnt vmcnt(0)" ::: "memory");
        const bf16_t* sl = s0 + (size_t)P.dbg * SLOT_ELEMS;
        for (size_t i = (size_t)c * 512 + threadIdx.x; i < (size_t)MTOK * DM; i += (size_t)G * 512) { float v = __uint_as_float((unsigned)sl[i] << 16) + DBG_ADD; if (!(fabsf(v) < 1e30f)) v = 12345.0f; P.out[i] = v; }
    }
#undef IN
#undef SEAM
}

extern "C" void kernel_launch(void* const* d_in, const int* in_sizes, int n_in, void* d_out, int out_size, void* d_ws, size_t ws_size, hipStream_t stream) {
    static int grid = 0;
    if (grid == 0) {
        if (n_in != 21 || ws_size < WS_NEED) { fprintf(stderr, "kernel_launch: unexpected n_in %d / ws_size %zu (need %zu)\n", n_in, ws_size, (size_t)WS_NEED); grid = -1; return; }
        int dev = 0, cus = 0, per_cu = 0;
        hipGetDevice(&dev); hipDeviceGetAttribute(&cus, hipDeviceAttributeMultiprocessorCount, dev);
        if (hipFuncSetAttribute((const void*)mega, hipFuncAttributeMaxDynamicSharedMemorySize, LDS_BYTES) != hipSuccess) { fprintf(stderr, "kernel_launch: hipFuncSetAttribute failed\n"); grid = -1; return; }
        if (hipOccupancyMaxActiveBlocksPerMultiprocessor(&per_cu, (const void*)mega, 512, LDS_BYTES) != hipSuccess || per_cu < 1) { fprintf(stderr, "kernel_launch: occupancy query gave %d\n", per_cu); per_cu = 1; }
        (void)hipGetLastError();
        grid = cus * per_cu;
    }
    if (grid < 0) return;
    Params p{};
    for (int i = 0; i < 21; ++i) p.in[i] = (const float*)d_in[i];
    p.out = (float*)d_out; p.ws = (unsigned char*)d_ws; p.lo = 0; p.hi = DBG_HI; p.dbg = DBG_SLOT;
    void* args[] = {&p};
    hipError_t e = hipLaunchCooperativeKernel((const void*)mega, dim3(grid), dim3(512), args, LDS_BYTES, stream);
    if (e != hipSuccess) fprintf(stderr, "cooperative launch failed: %s (grid %d)\n", hipGetErrorString(e), grid);
}
```

```cpp
#include <hip/hip_runtime.h>
#include <hip/hip_cooperative_groups.h>
#include <cstdio>
#include <cstdint>
namespace cg = cooperative_groups;

#define LAS __attribute__((address_space(3)))
typedef unsigned short bf16_t;
typedef short bf16x8 __attribute__((ext_vector_type(8)));
typedef float f32x4 __attribute__((ext_vector_type(4)));
typedef float f32x16 __attribute__((ext_vector_type(16)));
typedef unsigned u32x4 __attribute__((ext_vector_type(4)));
typedef unsigned u32x2 __attribute__((ext_vector_type(2)));

constexpr int BATCH = 16, SEQ = 2048, DM = 1024, MTOK = BATCH * SEQ, NH = 8, HD = 128, DFF = 2816, NGU = 2 * DFF, NLAYER = 2;
constexpr float EPS = 1e-6f;
#ifndef DBG_HI
#define DBG_HI 20
#define DBG_ADD 0.f
#define DBG_SLOT (-1)
#define DBG_OUT_OFF 0
#endif
constexpr size_t MiB = 1u << 20;
constexpr size_t SLOT_BYTES = 64 * MiB, SLOT_ELEMS = SLOT_BYTES / 2;
constexpr size_t W_IN = 0, W_POOL = 16 * MiB, W_BR = W_POOL + MiB / 2, W_OUT = W_BR + 6 * MiB, W_GU = W_OUT + 2 * MiB, W_DOWN = W_GU + 11 * MiB;
constexpr size_t SLOT0 = 42 * MiB;
static_assert(W_DOWN + (size_t)DM * DFF * 2 <= SLOT0, "weight map");
constexpr size_t WS_CTL = SLOT0 + 7 * SLOT_BYTES;
constexpr size_t CTL_BYTES = 16384;
constexpr size_t W_EFF = WS_CTL + 1 * MiB;
constexpr size_t WS_NEED = W_EFF + 2 * MiB;
constexpr int LDS_BYTES = 147456;

typedef __bf16 bf16v2_t __attribute__((ext_vector_type(2)));
typedef float f32v2_t __attribute__((ext_vector_type(2)));
__device__ __forceinline__ unsigned cvt_pk_bf16(float lo, float hi) { const f32v2_t f = {lo, hi}; const bf16v2_t v = __builtin_convertvector(f, bf16v2_t); return __builtin_bit_cast(unsigned, v); }
__device__ __forceinline__ float bf_lo(unsigned u) { return __uint_as_float(u << 16); }
__device__ __forceinline__ float bf_hi(unsigned u) { return __uint_as_float(u & 0xffff0000u); }
__device__ __forceinline__ float fast_sigmoid(float x) { return __builtin_amdgcn_rcpf(1.0f + __expf(-x)); }
__device__ __forceinline__ float wave_sum(float v) {
#pragma unroll
    for (int o = 1; o < 64; o <<= 1) v += __shfl_xor(v, o);
    return v;
}

namespace pg8 {
constexpr int BM = 256, BK = 64, HALF = 128, HTB = HALF * BK * 2, STAGE_BYTES = 8 * HTB, NXCD = 8, WGM = 8;
__host__ __device__ __forceinline__ int lds_byte(int r, int c) { const int st = (r >> 4) * 2 + (c >> 5), rr = r & 15, cc = c & 31, ob = rr * 64 + cc * 2; return st * 1024 + (ob ^ (((ob >> 9) & 1) << 5)); }
__host__ __device__ __forceinline__ void stage_rc(int b, int& R, int& C) { const int st = b / 1024, sb = b % 1024, swz = sb ^ (((sb >> 9) & 1) << 5); R = (st >> 1) * 16 + swz / 64; C = (st & 1) * 32 + (swz % 64) / 2; }
__host__ __device__ __forceinline__ int perm32(int rho) { const int n = rho >> 4, i = rho & 15; return 8 * (i >> 2) + 4 * n + (i & 3); }

struct Unit { int pm, pn, z; };
template <int M_, int N_, int K_, int LDA_, int LDB_, int NZ_ = 1, int APN_ = 0, long AZ_ = 0, long BZ_ = 0>
struct Cfg { static constexpr int nM = M_ / BM, nN = N_ / BM, nwg = nM * nN, K = K_, LDA = LDA_, LDB = LDB_, NZ = NZ_, APN = APN_; static constexpr long AZ = AZ_, BZ = BZ_;
    static __device__ __forceinline__ size_t aoff(const Unit& u) { return (size_t)u.z * AZ + (size_t)u.pm * (BM * LDA) + (size_t)u.pn * APN; }
    static __device__ __forceinline__ size_t boff(const Unit& u) { return (size_t)u.z * BZ + (size_t)u.pn * (BM * LDB); }
    static __device__ __forceinline__ void fix(Unit&) {} };
template <int K_, int LDA_>
struct CfgPair { static constexpr int nM = MTOK / BM, nN = DM / BM / 2, nwg = nM * nN, K = K_, LDA = LDA_, LDB = K_, NZ = 2;
    static __device__ __forceinline__ size_t aoff(const Unit& u) { return (size_t)u.pm * (BM * LDA); }
    static __device__ __forceinline__ size_t boff(const Unit& u) { return (size_t)u.pn * (BM * LDB); }
    static __device__ __forceinline__ void fix(Unit& u) { u.pn = 2 * u.pn + u.z; u.z = 0; } };
struct CfgGM { static constexpr int nM = MTOK / BM, nN = DM / BM, nwg = nM * nN, K = DM, LDA = DM, LDB = DM, NZ = 6;
    static __device__ __forceinline__ void fix(Unit& u) { const int z6 = u.z; u.z = (z6 < 3) ? 2 * z6 : 2 * (z6 - 3) + 1; }
    static __device__ __forceinline__ size_t aoff(const Unit& u) { return ((u.z & 1) ? (size_t)(1 + (u.z >> 1)) * SLOT_ELEMS : (size_t)0) + (size_t)u.pm * (BM * DM); }
    static __device__ __forceinline__ size_t boff(const Unit& u) { return ((u.z & 1) ? ((u.z == 1) ? (size_t)(W_EFF / 2) : (size_t)(W_BR / 2) + (size_t)(u.z >> 1) * DM * DM) : (size_t)(5120 + (u.z >> 1) * DM) * DM) + (size_t)u.pn * (BM * DM); } };
template <class C>
__device__ __forceinline__ bool next_unit(int i, int G, int c, Unit& u) {
    const int round = i / C::NZ; u.z = i - round * C::NZ;
    const int L = round * G + c; if (L >= C::nwg) return false;
    int wgid = L; { constexpr int q = C::nwg / NXCD, r = C::nwg % NXCD; const int xcd = wgid % NXCD, off = wgid / NXCD; wgid = (xcd < r ? xcd * (q + 1) : r * (q + 1) + (xcd - r) * q) + off; }
    constexpr int nig = WGM * C::nN; const int gid = wgid / nig, fm = gid * WGM, gsz = (C::nM - fm) < WGM ? (C::nM - fm) : WGM;
    u.pm = fm + ((wgid % nig) % gsz); u.pn = (wgid % nig) / gsz; C::fix(u); return true;
}

template <class C, class Epi>
__device__ __forceinline__ void gemm_phase(LAS unsigned char* lds, const bf16_t* gA, const bf16_t* gBt, const int G, const int c, const Epi& E) {
    int tid = threadIdx.x; asm volatile("" : "+v"(tid));
    const int wid = __builtin_amdgcn_readfirstlane(tid >> 6), lane = tid & 63, wr = wid >> 2, wc = wid & 3, fr = lane & 15, fq = lane >> 4;
    constexpr int nt = C::K / BK;
    unsigned voffA[2], voffB[2];
#pragma unroll
    for (int i = 0; i < 2; ++i) { int R, Cc; stage_rc(tid * 16 + i * 8192, R, Cc); const int Rb = Epi::PERM ? ((R & ~31) + perm32(R & 31)) : R;
        voffA[i] = (unsigned)(R * C::LDA + Cc) * 2u; voffB[i] = (unsigned)(Rb * C::LDB + Cc) * 2u; }
    constexpr unsigned kstep = BK * 2;
    constexpr unsigned hstepA = HALF * C::LDA * 2, hstepB = HALF * C::LDB * 2;
    const unsigned ldsw = (unsigned)wid * 1024u;
    const int aoff = lds_byte(wr * 64 + fr, fq * 8), boff = lds_byte(wc * 32 + fr, fq * 8);
#define PG8_APTR(u) ((const char*)gA + C::aoff(u) * 2)
#define PG8_BPTR(u) ((const char*)gBt + C::boff(u) * 2)
#define PG8_SA(b, h) (((b) * 2 + (h)) * HTB)
#define PG8_SB(b, h) ((4 + (b) * 2 + (h)) * HTB)
#define PG8_STAGE(bufoff, gbase, voff) do { _Pragma("unroll") for (int _i = 0; _i < 2; ++_i) \
        __builtin_amdgcn_global_load_lds((const unsigned*)((const char*)(gbase) + (voff)[_i]), (LAS unsigned*)(lds + (bufoff) + ldsw + _i * 8192), 16, 0, 0); } while (0)
#define PG8_LDA(dst, b, h) do { _Pragma("unroll") for (int m = 0; m < 4; ++m) _Pragma("unroll") for (int k = 0; k < 2; ++k) dst[m][k] = *(const LAS bf16x8*)(lds + PG8_SA(b, h) + aoff + m * 2048 + k * 1024); } while (0)
#define PG8_LDB(dst, b, h) do { _Pragma("unroll") for (int n = 0; n < 2; ++n) _Pragma("unroll") for (int k = 0; k < 2; ++k) dst[n][k] = *(const LAS bf16x8*)(lds + PG8_SB(b, h) + boff + n * 2048 + k * 1024); } while (0)
#define PG8_MMA(ai, bj, At, Bt) do { __builtin_amdgcn_s_setprio(1); _Pragma("unroll") for (int m = 0; m < 4; ++m) _Pragma("unroll") for (int n = 0; n < 2; ++n) _Pragma("unroll") for (int k = 0; k < 2; ++k) \
        acc[ai][bj][m][n] = __builtin_amdgcn_mfma_f32_16x16x32_bf16(Bt[n][k], At[m][k], acc[ai][bj][m][n], 0, 0, 0); __builtin_amdgcn_s_setprio(0); } while (0)
#define PG8_WAIT_V(n) asm volatile("s_waitcnt vmcnt(" #n ")" ::: "memory")
#define PG8_WAIT_L(n) asm volatile("s_waitcnt lgkmcnt(" #n ")" ::: "memory")
#define PG8_BAR __builtin_amdgcn_s_barrier()
#define PG8_SCHED __builtin_amdgcn_sched_barrier(0)
    Unit cur, nxt; int ui = 0;
    if (!next_unit<C>(0, G, c, cur)) return;
    f32x4 acc[2][2][4][2];
#pragma unroll
    for (int a = 0; a < 2; ++a)
#pragma unroll
        for (int b = 0; b < 2; ++b)
#pragma unroll
            for (int m = 0; m < 4; ++m)
#pragma unroll
                for (int n = 0; n < 2; ++n) acc[a][b][m][n] = (f32x4){0.f, 0.f, 0.f, 0.f};
    bf16x8 At[4][2], B0[2][2], B1[2][2];
    const char* cA = PG8_APTR(cur); const char* cB = PG8_BPTR(cur);
    PG8_STAGE(PG8_SB(0, 0), cB, voffB); PG8_STAGE(PG8_SB(0, 1), cB + hstepB, voffB); PG8_STAGE(PG8_SA(0, 0), cA, voffA); PG8_STAGE(PG8_SA(0, 1), cA + hstepA, voffA);
    if (wr == 1) PG8_BAR;
    PG8_WAIT_V(2); PG8_BAR;
    PG8_STAGE(PG8_SB(1, 0), cB + kstep, voffB); PG8_STAGE(PG8_SA(1, 0), cA + kstep, voffA); PG8_STAGE(PG8_SB(1, 1), cB + hstepB + kstep, voffB);
    PG8_WAIT_V(6); PG8_BAR;
    for (;;) {
        const bool has_next = next_unit<C>(ui + 1, G, c, nxt);
        const char* nA = has_next ? PG8_APTR(nxt) : cA; const char* nB = has_next ? PG8_BPTR(nxt) : cB;
#pragma nounroll
        for (int t = 0; t < nt; t += 2) {
            const bool last = (t == nt - 2);
            const char* a1 = cA + (t + 1) * kstep;
            const char* a2 = last ? nA : cA + (t + 2) * kstep; const char* b2 = last ? nB : cB + (t + 2) * kstep;
            const char* a3 = a2 + kstep; const char* b3 = b2 + kstep;
            PG8_LDB(B0, 0, 0); PG8_LDB(B1, 0, 1); PG8_SCHED; PG8_LDA(At, 0, 0); PG8_STAGE(PG8_SA(1, 1), a1 + hstepA, voffA);
            PG8_WAIT_V(8); PG8_WAIT_L(0); PG8_BAR; PG8_MMA(0, 0, At, B0); PG8_MMA(0, 1, At, B1); PG8_BAR; PG8_SCHED;
            PG8_LDA(At, 0, 1); PG8_STAGE(PG8_SB(0, 0), b2, voffB); PG8_STAGE(PG8_SB(0, 1), b2 + hstepB, voffB); PG8_STAGE(PG8_SA(0, 0), a2, voffA);
            PG8_WAIT_V(8); PG8_WAIT_L(0); PG8_BAR; PG8_MMA(1, 0, At, B0); PG8_MMA(1, 1, At, B1); PG8_BAR; PG8_SCHED;
            PG8_LDB(B0, 1, 0); PG8_LDB(B1, 1, 1); PG8_SCHED; PG8_LDA(At, 1, 0); PG8_STAGE(PG8_SA(0, 1), a2 + hstepA, voffA);
            PG8_WAIT_V(8); PG8_WAIT_L(0); PG8_BAR; PG8_MMA(0, 0, At, B0); PG8_MMA(0, 1, At, B1); PG8_BAR; PG8_SCHED;
            PG8_LDA(At, 1, 1); PG8_STAGE(PG8_SB(1, 0), b3, voffB); PG8_STAGE(PG8_SB(1, 1), b3 + hstepB, voffB); PG8_STAGE(PG8_SA(1, 0), a3, voffA);
            PG8_WAIT_V(8); PG8_WAIT_L(0); PG8_BAR; PG8_MMA(1, 0, At, B0); PG8_MMA(1, 1, At, B1); PG8_BAR; PG8_SCHED;
        }
        if (wr == 0) PG8_BAR;
        E(acc, cur, wr, wc, fr, fq);
        if (!has_next) break;
#pragma unroll
        for (int a = 0; a < 2; ++a)
#pragma unroll
            for (int b = 0; b < 2; ++b)
#pragma unroll
                for (int m = 0; m < 4; ++m)
#pragma unroll
                    for (int n = 0; n < 2; ++n) acc[a][b][m][n] = (f32x4){0.f, 0.f, 0.f, 0.f};
        cur = nxt; cA = nA; cB = nB; ++ui;
        if (wr == 1) PG8_BAR;
    }
    PG8_WAIT_V(0);
    PG8_BAR;
#undef PG8_APTR
#undef PG8_BPTR
#undef PG8_SA
#undef PG8_SB
#undef PG8_STAGE
#undef PG8_LDA
#undef PG8_LDB
#undef PG8_MMA
#undef PG8_WAIT_V
#undef PG8_WAIT_L
#undef PG8_BAR
#undef PG8_SCHED
}

typedef f32x4 Acc[2][2][4][2];

struct EpiInProj {
    static constexpr bool PERM = true;
    bf16_t* base; bf16_t* vT; LAS float* X; const float* qg; const float* kg;
    __device__ __forceinline__ void operator()(const Acc& acc, const Unit& u, int wr, int wc, int fr, int fq) const {
        asm volatile("" : "+v"(fr), "+v"(fq));
        const int row0 = u.pm * BM + wr * 64 + fr;
        if (u.pn >= 8 && u.pn < 16) {
            bf16_t* dst = base + (size_t)(u.pn >> 2) * SLOT_ELEMS; const int col0 = (u.pn & 3) * 256 + wc * 32 + 8 * fq;
#pragma unroll
            for (int ai = 0; ai < 2; ++ai)
#pragma unroll
                for (int m = 0; m < 4; ++m)
#pragma unroll
                    for (int bj = 0; bj < 2; ++bj) { const f32x4 v0 = acc[ai][bj][m][0], v1 = acc[ai][bj][m][1];
                        float s = ((v0[0] * v0[0] + v0[1] * v0[1]) + (v0[2] * v0[2] + v0[3] * v0[3])) + ((v1[0] * v1[0] + v1[1] * v1[1]) + (v1[2] * v1[2] + v1[3] * v1[3]));
                        s += __shfl_xor(s, 16); s += __shfl_xor(s, 32);
                        if (fq == 0) X[((wr * 4 + wc) * 16 + (ai * 4 + m) * 2 + bj) * 16 + fr] = s; asm volatile("" ::: "memory"); }
            asm volatile("s_waitcnt lgkmcnt(0)" ::: "memory"); __builtin_amdgcn_s_barrier(); asm volatile("" ::: "memory");
            const float* gsrc = ((u.pn < 12) ? qg : kg) + wc * 32 + 8 * fq;
            const f32x4 g0 = *(const f32x4*)gsrc, g1 = *(const f32x4*)(gsrc + 4);
#pragma unroll
            for (int ai = 0; ai < 2; ++ai)
#pragma unroll
                for (int m = 0; m < 4; ++m) { bf16_t* rowp = dst + (size_t)(row0 + ai * HALF + m * 16) * DM + col0;
#pragma unroll
                    for (int bj = 0; bj < 2; ++bj) { const int xi = ((ai * 4 + m) * 2 + bj) * 16 + fr;
                        const float tot = (X[(wr * 4 + 0) * 256 + xi] + X[(wr * 4 + 1) * 256 + xi]) + (X[(wr * 4 + 2) * 256 + xi] + X[(wr * 4 + 3) * 256 + xi]);
                        const float rstd = rsqrtf(tot * (1.f / HD) + EPS);
                        const f32x4 v0 = acc[ai][bj][m][0] * rstd * g0, v1 = acc[ai][bj][m][1] * rstd * g1; u32x4 w;
                        w.x = cvt_pk_bf16(v0[0], v0[1]); w.y = cvt_pk_bf16(v0[2], v0[3]); w.z = cvt_pk_bf16(v1[0], v1[1]); w.w = cvt_pk_bf16(v1[2], v1[3]);
                        *(u32x4*)(rowp + bj * HALF) = w; asm volatile("" ::: "memory"); } }
        } else if (u.pn < 8) {
            bf16_t* dst = base + (size_t)((u.pn >> 2) ? 1 : 5) * SLOT_ELEMS; const int col0 = (u.pn & 3) * 256 + wc * 32 + 8 * fq;
#pragma unroll
            for (int ai = 0; ai < 2; ++ai)
#pragma unroll
                for (int m = 0; m < 4; ++m) { bf16_t* rowp = dst + (size_t)(row0 + ai * HALF + m * 16) * DM + col0;
#pragma unroll
                    for (int bj = 0; bj < 2; ++bj) { const f32x4 v0 = acc[ai][bj][m][0], v1 = acc[ai][bj][m][1]; u32x4 w;
                        w.x = cvt_pk_bf16(v0[0], v0[1]); w.y = cvt_pk_bf16(v0[2], v0[3]); w.z = cvt_pk_bf16(v1[0], v1[1]); w.w = cvt_pk_bf16(v1[2], v1[3]);
                        *(u32x4*)(rowp + bj * HALF) = w; } }
        } else {
            LAS unsigned char* Wb = (LAS unsigned char*)X + (wr * 4 + wc) * 1024;
            const int lane_ = fq * 16 + fr, dr = lane_ >> 1, hf = lane_ & 1;
#pragma unroll
            for (int ai = 0; ai < 2; ++ai)
#pragma unroll
                for (int m = 0; m < 4; ++m) { const int rowb = u.pm * BM + wr * 64 + ai * HALF + m * 16; const int b = rowb >> 11, s0 = rowb & 2047;
#pragma unroll
                    for (int bj = 0; bj < 2; ++bj) { const int head = (u.pn - 16) * 2 + bj;
                        asm volatile("" ::: "memory");
#pragma unroll
                        for (int n = 0; n < 2; ++n) { const f32x4 v = acc[ai][bj][m][n];
                            const unsigned w0 = cvt_pk_bf16(v[0], v[1]), w1 = cvt_pk_bf16(v[2], v[3]);
                            LAS unsigned short* wp = (LAS unsigned short*)(Wb + (8 * fq + 4 * n) * 32 + fr * 2);
                            wp[0] = (unsigned short)(w0 & 0xffffu); wp[16] = (unsigned short)(w0 >> 16); wp[32] = (unsigned short)(w1 & 0xffffu); wp[48] = (unsigned short)(w1 >> 16); }
                        asm volatile("s_waitcnt lgkmcnt(0)" ::: "memory");
                        const u32x4 t4 = *(const LAS u32x4*)(Wb + dr * 32 + hf * 16);
                        *(u32x4*)(vT + ((size_t)((b * NH + head) * HD + wc * 32 + dr)) * SEQ + s0 + hf * 8) = t4;
                        asm volatile("s_waitcnt lgkmcnt(0)" ::: "memory"); } }
        }
    }
};
template <int MODE> struct EpiColOp {
    static constexpr bool PERM = true;
    bf16_t* O; int ldc; const float* vec;
    __device__ __forceinline__ void operator()(const Acc& acc, const Unit& u, int wr, int wc, int fr, int fq) const {
        const int row0 = u.pm * BM + wr * 64 + fr, col0 = u.pn * BM + wc * 32 + 8 * fq;
        f32x4 bv[2][2];
#pragma unroll
        for (int bj = 0; bj < 2; ++bj)
#pragma unroll
            for (int n = 0; n < 2; ++n) bv[bj][n] = (MODE == 2) ? (f32x4){1.f, 1.f, 1.f, 1.f} : *(const f32x4*)(vec + col0 + bj * HALF + 4 * n);
#pragma unroll
        for (int ai = 0; ai < 2; ++ai)
#pragma unroll
            for (int m = 0; m < 4; ++m) { bf16_t* rowp = O + (size_t)(row0 + ai * HALF + m * 16) * ldc + col0;
#pragma unroll
                for (int bj = 0; bj < 2; ++bj) { f32x4 v0 = acc[ai][bj][m][0], v1 = acc[ai][bj][m][1];
                    if (MODE == 0) { v0 = v0 + bv[bj][0]; v1 = v1 + bv[bj][1];
#pragma unroll
                        for (int j = 0; j < 4; ++j) { v0[j] = fast_sigmoid(v0[j]); v1[j] = fast_sigmoid(v1[j]); } }
                    else { v0 = v0 * bv[bj][0]; v1 = v1 * bv[bj][1]; }
                    u32x4 w; w.x = cvt_pk_bf16(v0[0], v0[1]); w.y = cvt_pk_bf16(v0[2], v0[3]); w.z = cvt_pk_bf16(v1[0], v1[1]); w.w = cvt_pk_bf16(v1[2], v1[3]);
                    *(u32x4*)(rowp + bj * HALF) = w; } }
    }
};
struct EpiMerge {
    static constexpr bool PERM = true;
    const bf16_t* gates; bf16_t* merged;
    __device__ __forceinline__ void operator()(const Acc& acc, const Unit& u, int wr, int wc, int fr, int fq) const {
        const int row0 = u.pm * BM + wr * 64 + fr, col0 = u.pn * BM + wc * 32 + 8 * fq;
#pragma unroll
        for (int ai = 0; ai < 2; ++ai)
#pragma unroll
            for (int m = 0; m < 4; ++m) { const size_t row = (size_t)(row0 + ai * HALF + m * 16);
#pragma unroll
                for (int bj = 0; bj < 2; ++bj) { const int col = col0 + bj * HALF;
                    const u32x4 gv = *(const u32x4*)(gates + row * (3 * DM) + u.z * DM + col);
                    u32x4 pv = (u32x4){0u, 0u, 0u, 0u}; if (u.z > 0) pv = *(const u32x4*)(merged + row * DM + col);
                    const f32x4 v0 = acc[ai][bj][m][0], v1 = acc[ai][bj][m][1]; u32x4 w;
                    w.x = cvt_pk_bf16(bf_lo(pv.x) + bf_lo(gv.x) * v0[0], bf_hi(pv.x) + bf_hi(gv.x) * v0[1]);
                    w.y = cvt_pk_bf16(bf_lo(pv.y) + bf_lo(gv.y) * v0[2], bf_hi(pv.y) + bf_hi(gv.y) * v0[3]);
                    w.z = cvt_pk_bf16(bf_lo(pv.z) + bf_lo(gv.z) * v1[0], bf_hi(pv.z) + bf_hi(gv.z) * v1[1]);
                    w.w = cvt_pk_bf16(bf_lo(pv.w) + bf_lo(gv.w) * v1[2], bf_hi(pv.w) + bf_hi(gv.w) * v1[3]);
                    *(u32x4*)(merged + row * DM + col) = w; } }
    }
};
struct EpiGateMerge {
    static constexpr bool PERM = true;
    bf16_t* scr01; bf16_t* scr2; bf16_t* merged; const float* bgate;
    __device__ __forceinline__ void operator()(const Acc& acc, const Unit& u, int wr, int wc, int fr, int fq) const {
        asm volatile("" : "+v"(fr), "+v"(fq));
        const int lrow0 = wr * 64 + fr, lcol0 = wc * 32 + 8 * fq;
        bf16_t* scratch = ((u.z >> 1) < 2) ? scr01 + (u.z >> 1) * 65536 : scr2;
        if (!(u.z & 1)) {
            const float* bp = bgate + (u.z >> 1) * DM + u.pn * BM + lcol0;
            f32x4 bv[2][2];
#pragma unroll
            for (int bj = 0; bj < 2; ++bj)
#pragma unroll
                for (int n = 0; n < 2; ++n) bv[bj][n] = *(const f32x4*)(bp + bj * HALF + 4 * n);
#pragma unroll
            for (int ai = 0; ai < 2; ++ai)
#pragma unroll
                for (int m = 0; m < 4; ++m) { bf16_t* rowp = scratch + (lrow0 + ai * HALF + m * 16) * 256 + lcol0;
#pragma unroll
                    for (int bj = 0; bj < 2; ++bj) { f32x4 v0 = acc[ai][bj][m][0] + bv[bj][0], v1 = acc[ai][bj][m][1] + bv[bj][1];
#pragma unroll
                        for (int j = 0; j < 4; ++j) { v0[j] = fast_sigmoid(v0[j]); v1[j] = fast_sigmoid(v1[j]); }
                        u32x4 w; w.x = cvt_pk_bf16(v0[0], v0[1]); w.y = cvt_pk_bf16(v0[2], v0[3]); w.z = cvt_pk_bf16(v1[0], v1[1]); w.w = cvt_pk_bf16(v1[2], v1[3]);
                        *(u32x4*)(rowp + bj * HALF) = w; } }
        } else {
#pragma unroll
            for (int ai = 0; ai < 2; ++ai)
#pragma unroll
                for (int m = 0; m < 4; ++m) { const int lrow = lrow0 + ai * HALF + m * 16; bf16_t* mrow = merged + (size_t)(u.pm * BM + lrow) * DM + u.pn * BM + lcol0;
#pragma unroll
                    for (int bj = 0; bj < 2; ++bj) {
                        const u32x4 gv = *(const u32x4*)(scratch + lrow * 256 + lcol0 + bj * HALF);
                        u32x4 pv = (u32x4){0u, 0u, 0u, 0u}; if (u.z > 1) pv = *(const u32x4*)(mrow + bj * HALF);
                        const f32x4 v0 = acc[ai][bj][m][0], v1 = acc[ai][bj][m][1]; u32x4 w;
                        w.x = cvt_pk_bf16(bf_lo(pv.x) + bf_lo(gv.x) * v0[0], bf_hi(pv.x) + bf_hi(gv.x) * v0[1]);
                        w.y = cvt_pk_bf16(bf_lo(pv.y) + bf_lo(gv.y) * v0[2], bf_hi(pv.y) + bf_hi(gv.y) * v0[3]);
                        w.z = cvt_pk_bf16(bf_lo(pv.z) + bf_lo(gv.z) * v1[0], bf_hi(pv.z) + bf_hi(gv.z) * v1[1]);
                        w.w = cvt_pk_bf16(bf_lo(pv.w) + bf_lo(gv.w) * v1[2], bf_hi(pv.w) + bf_hi(gv.w) * v1[3]);
                        *(u32x4*)(mrow + bj * HALF) = w; } }
        }
    }
};
struct EpiResid {
    static constexpr bool PERM = false;
    const float* base; float* out;
    __device__ __forceinline__ void operator()(const Acc& acc, const Unit& u, int wr, int wc, int fr, int fq) const {
        const int row0 = u.pm * BM + wr * 64 + fr, col0 = u.pn * BM + wc * 32 + 4 * fq;
#pragma unroll
        for (int ai = 0; ai < 2; ++ai)
#pragma unroll
            for (int m = 0; m < 4; ++m) { const size_t off = (size_t)(row0 + ai * HALF + m * 16) * DM + col0;
#pragma unroll
                for (int bj = 0; bj < 2; ++bj)
#pragma unroll
                    for (int n = 0; n < 2; ++n) { const f32x4 bs = *(const f32x4*)(base + off + bj * HALF + n * 16);
                        *(f32x4*)(out + off + bj * HALF + n * 16) = bs + acc[ai][bj][m][n]; } }
    }
};
struct EpiSwiglu {
    static constexpr bool PERM = true;
    bf16_t* act;
    __device__ __forceinline__ void operator()(const Acc& acc, const Unit& u, int wr, int wc, int fr, int fq) const {
        const int row0 = u.pm * BM + wr * 64 + fr, col0 = u.pn * 128 + wc * 32 + 8 * fq;
#pragma unroll
        for (int ai = 0; ai < 2; ++ai)
#pragma unroll
            for (int m = 0; m < 4; ++m) { bf16_t* rowp = act + (size_t)(row0 + ai * HALF + m * 16) * DFF + col0;
                f32x4 r0, r1; const f32x4 g0 = acc[ai][0][m][0], g1 = acc[ai][0][m][1], u0 = acc[ai][1][m][0], u1 = acc[ai][1][m][1];
#pragma unroll
                for (int j = 0; j < 4; ++j) { r0[j] = g0[j] * fast_sigmoid(g0[j]) * u0[j]; r1[j] = g1[j] * fast_sigmoid(g1[j]) * u1[j]; }
                u32x4 w; w.x = cvt_pk_bf16(r0[0], r0[1]); w.y = cvt_pk_bf16(r0[2], r0[3]); w.z = cvt_pk_bf16(r1[0], r1[1]); w.w = cvt_pk_bf16(r1[2], r1[3]);
                *(u32x4*)rowp = w; }
    }
};
}

__device__ __forceinline__ void transpose_item(const float* W, int K, int N, bf16_t* WT, int row_off, int mode, LAS float* scr, int item, int lane) {
    const int nblk = N / 32, kb = item / nblk, nb = item % nblk, k0 = 64 * kb, n0 = 32 * nb;
    const float* wp = W + (size_t)(k0 + (lane >> 5)) * N + n0 + (lane & 31);
    float wv[32];
#pragma unroll
    for (int i = 0; i < 32; ++i) wv[i] = wp[(size_t)(2 * i) * N];
#pragma unroll
    for (int i = 0; i < 32; ++i) scr[(2 * i + (lane >> 5)) * 33 + (lane & 31)] = wv[i];
    asm volatile("s_waitcnt lgkmcnt(0)" ::: "memory");
    const int c = lane & 7;
#pragma unroll
    for (int j = 0; j < 4; ++j) { const int n = (lane >> 3) + 8 * j; const LAS float* s = scr + (8 * c) * 33 + n;
        u32x4 o; o.x = cvt_pk_bf16(s[0 * 33], s[1 * 33]); o.y = cvt_pk_bf16(s[2 * 33], s[3 * 33]); o.z = cvt_pk_bf16(s[4 * 33], s[5 * 33]); o.w = cvt_pk_bf16(s[6 * 33], s[7 * 33]);
        const int ng = n0 + n; const int drow = (mode == 0) ? (row_off + ng) : (256 * (ng >> 7) + (ng & 127) + 128 * (mode - 1));
        *(u32x4*)(WT + (size_t)drow * K + k0 + 8 * c) = o; }
    asm volatile("s_waitcnt lgkmcnt(0)" ::: "memory");
}

struct Params { const float* in[21]; float* out; unsigned char* ws; int lo, hi, dbg, pad; };

__device__ __forceinline__ void convert_weights(const Params& P, int l, LAS unsigned char* lds, int gw, int NGW, int wave, int lane) {
    LAS float* scr = (LAS float*)(lds + wave * 16384);
    unsigned char* ws = P.ws;
    constexpr int I_IN = 16 * 256, I_POOL = 4 * 8, I_BR = 16 * 32, I_OUT = 16 * 32, I_G = 16 * 88, I_D = 44 * 32;
    constexpr int NITEMS = I_IN + 4 * I_POOL + 3 * I_BR + I_OUT + 2 * I_G + I_D;
    for (int it = gw; it < NITEMS; it += NGW) {
        int r = it;
        if (r < I_IN) { transpose_item(P.in[2] + (size_t)l * DM * 8192, DM, 8192, (bf16_t*)(ws + W_IN), 0, 0, scr, r, lane); continue; } r -= I_IN;
        if (r < 4 * I_POOL) {
            const int row0 = r * 8;
#pragma unroll
            for (int rr = 0; rr < 8; ++rr) { const int row = row0 + rr; const int g = row >> 8;
                const f32x4 wv4 = *(const f32x4*)(P.in[4] + (size_t)l * 4 * 65536 + (size_t)row * 256 + lane * 4);
                const f32x4 sc4 = *(const f32x4*)(P.in[5] + (size_t)l * DM + g * 256 + lane * 4);
                u32x2 o; o.x = cvt_pk_bf16(wv4[0] * sc4[0], wv4[1] * sc4[1]); o.y = cvt_pk_bf16(wv4[2] * sc4[2], wv4[3] * sc4[3]);
                *(u32x2*)((bf16_t*)(ws + W_POOL) + (size_t)row * 256 + lane * 4) = o; }
            continue; } r -= 4 * I_POOL;
        if (r < 3 * I_BR) { const int b = r / I_BR; transpose_item(P.in[15] + (size_t)(l * 3 + b) * DM * DM, DM, DM, (bf16_t*)(ws + W_BR) + (size_t)b * DM * DM, 0, 0, scr, r % I_BR, lane); continue; } r -= 3 * I_BR;
        if (r < I_OUT) { transpose_item(P.in[16] + (size_t)l * DM * DM, DM, DM, (bf16_t*)(ws + W_OUT), 0, 0, scr, r, lane); continue; } r -= I_OUT;
        if (r < I_G) { transpose_item(P.in[18] + (size_t)l * DM * DFF, DM, DFF, (bf16_t*)(ws + W_GU), 0, 1, scr, r, lane); continue; } r -= I_G;
        if (r < I_G) { transpose_item(P.in[19] + (size_t)l * DM * DFF, DM, DFF, (bf16_t*)(ws + W_GU), 0, 2, scr, r, lane); continue; } r -= I_G;
        transpose_item(P.in[20] + (size_t)l * DFF * DM, DFF, DM, (bf16_t*)(ws + W_DOWN), 0, 0, scr, r, lane);
    }
}

__device__ __forceinline__ void rms_rows(const float* x, const float* g, bf16_t* out, int gw, int NGW, int lane) {
    f32x4 gg[4];
#pragma unroll
    for (int j = 0; j < 4; ++j) gg[j] = ((const f32x4*)g)[64 * j + lane];
    for (int m = gw; m < MTOK; m += 2 * NGW) {
        const int m2 = m + NGW; const bool has2 = m2 < MTOK;
        const f32x4* xr = (const f32x4*)(x + (size_t)m * DM) + lane; const f32x4* xr2 = (const f32x4*)(x + (size_t)(has2 ? m2 : m) * DM) + lane;
        f32x4 v[4], v2[4]; float s = 0.f, s2 = 0.f;
#pragma unroll
        for (int j = 0; j < 4; ++j) { v[j] = xr[64 * j]; v2[j] = xr2[64 * j]; }
#pragma unroll
        for (int j = 0; j < 4; ++j) { s += (v[j][0] * v[j][0] + v[j][1] * v[j][1]) + (v[j][2] * v[j][2] + v[j][3] * v[j][3]); s2 += (v2[j][0] * v2[j][0] + v2[j][1] * v2[j][1]) + (v2[j][2] * v2[j][2] + v2[j][3] * v2[j][3]); }
        const float rstd = rsqrtf(wave_sum(s) * (1.f / DM) + EPS), rstd2 = rsqrtf(wave_sum(s2) * (1.f / DM) + EPS);
        u32x2* o = (u32x2*)(out + (size_t)m * DM) + lane; u32x2* o2 = (u32x2*)(out + (size_t)m2 * DM) + lane;
#pragma unroll
        for (int j = 0; j < 4; ++j) { u32x2 w;
            w.x = cvt_pk_bf16(v[j][0] * rstd * gg[j][0], v[j][1] * rstd * gg[j][1]); w.y = cvt_pk_bf16(v[j][2] * rstd * gg[j][2], v[j][3] * rstd * gg[j][3]); o[64 * j] = w;
            if (has2) { w.x = cvt_pk_bf16(v2[j][0] * rstd2 * gg[j][0], v2[j][1] * rstd2 * gg[j][1]); w.y = cvt_pk_bf16(v2[j][2] * rstd2 * gg[j][2], v2[j][3] * rstd2 * gg[j][3]); o2[64 * j] = w; } }
    }
}

__device__ __forceinline__ void qk_norm_rows(bf16_t* q, bf16_t* k, const float* qg, const float* kg, int gw, int NGW, int lane) {
    const int d0 = (lane & 7) * 16;
    for (int it = gw; it < 2 * MTOK; it += NGW) {
        const int which = it >= MTOK; const int m = it - which * MTOK;
        bf16_t* p = (which ? k : q) + (size_t)m * DM + lane * 16; const float* gg = (which ? kg : qg) + d0;
        const u32x4 a = *(const u32x4*)p, b = *(const u32x4*)(p + 8);
        float v[16];
        v[0] = bf_lo(a.x); v[1] = bf_hi(a.x); v[2] = bf_lo(a.y); v[3] = bf_hi(a.y); v[4] = bf_lo(a.z); v[5] = bf_hi(a.z); v[6] = bf_lo(a.w); v[7] = bf_hi(a.w);
        v[8] = bf_lo(b.x); v[9] = bf_hi(b.x); v[10] = bf_lo(b.y); v[11] = bf_hi(b.y); v[12] = bf_lo(b.z); v[13] = bf_hi(b.z); v[14] = bf_lo(b.w); v[15] = bf_hi(b.w);
        float ss = 0.f;
#pragma unroll
        for (int e = 0; e < 16; ++e) ss += v[e] * v[e];
        ss += __shfl_xor(ss, 1); ss += __shfl_xor(ss, 2); ss += __shfl_xor(ss, 4);
        const float rstd = rsqrtf(ss * (1.f / HD) + EPS);
        unsigned w[8];
#pragma unroll
        for (int e = 0; e < 8; ++e) w[e] = cvt_pk_bf16(v[2 * e] * rstd * gg[2 * e], v[2 * e + 1] * rstd * gg[2 * e + 1]);
        *(u32x4*)p = (u32x4){w[0], w[1], w[2], w[3]}; *(u32x4*)(p + 8) = (u32x4){w[4], w[5], w[6], w[7]};
    }
}

__device__ __forceinline__ void unpack8(const u32x4 a, float (&v)[8]) { v[0] = bf_lo(a.x); v[1] = bf_hi(a.x); v[2] = bf_lo(a.y); v[3] = bf_hi(a.y); v[4] = bf_lo(a.z); v[5] = bf_hi(a.z); v[6] = bf_lo(a.w); v[7] = bf_hi(a.w); }
__device__ __forceinline__ void pool_elem(const bf16_t* u, bf16_t* p, int gtid, int NT) {
    for (int id = gtid; id < BATCH * 128 * 128; id += NT) {
        const int oct = id & 127, strip = (id >> 7) & 127, b = id >> 14;
        const int c0 = oct * 8, w = 2 << (c0 >> 8), t0 = strip * 16;
        const bf16_t* ub = u + (size_t)b * SEQ * DM + c0; bf16_t* pb = p + (size_t)b * SEQ * DM + c0;
        float S[8];
#pragma unroll
        for (int e = 0; e < 8; ++e) S[e] = 0.f;
        for (int k = 1; k <= w; ++k) { const int t = t0 - k; if (t >= 0) { float v[8]; unpack8(*(const u32x4*)(ub + (size_t)t * DM), v);
#pragma unroll
                for (int e = 0; e < 8; ++e) S[e] += v[e]; } }
        for (int i = 0; i < 16; ++i) { const int t = t0 + i; float v[8]; unpack8(*(const u32x4*)(ub + (size_t)t * DM), v);
            if (t - w >= 0) { float o[8]; unpack8(*(const u32x4*)(ub + (size_t)(t - w) * DM), o);
#pragma unroll
                for (int e = 0; e < 8; ++e) S[e] -= o[e]; }
            const float inv = 1.f / (float)((t + 1) < w ? (t + 1) : w); float r[8];
#pragma unroll
            for (int e = 0; e < 8; ++e) { S[e] += v[e]; r[e] = S[e] * inv - v[e]; }
            *(u32x4*)(pb + (size_t)t * DM) = (u32x4){cvt_pk_bf16(r[0], r[1]), cvt_pk_bf16(r[2], r[3]), cvt_pk_bf16(r[4], r[5]), cvt_pk_bf16(r[6], r[7])}; }
    }
}

__device__ __forceinline__ void pool_tile(const bf16_t* u, bf16_t* p, int pm, int g, int tid) {
    const int oct = tid & 31, strip = tid >> 5;
    const int c0 = g * 256 + oct * 8, w = 2 << g, row0 = pm * 256 + strip * 16, b = row0 >> 11, t0 = row0 & 2047;
    const bf16_t* ub = u + (size_t)b * SEQ * DM + c0; bf16_t* pb = p + (size_t)b * SEQ * DM + c0;
    float S[8];
#pragma unroll
    for (int e = 0; e < 8; ++e) S[e] = 0.f;
#pragma unroll 8
    for (int k = 1; k <= 16; ++k) { const int t = t0 - k; if (k <= w && t >= 0) { float v[8]; unpack8(*(const u32x4*)(ub + (size_t)t * DM), v);
#pragma unroll
            for (int e = 0; e < 8; ++e) S[e] += v[e]; } }
#pragma unroll 4
    for (int i = 0; i < 16; ++i) { const int t = t0 + i; float v[8], o[8]; unpack8(*(const u32x4*)(ub + (size_t)t * DM), v);
        const int tl = (t - w >= 0) ? (t - w) : t; unpack8(*(const u32x4*)(ub + (size_t)tl * DM), o);
        const float keep = (t - w >= 0) ? 1.f : 0.f;
        const float inv = 1.f / (float)((t + 1) < w ? (t + 1) : w); float r[8];
#pragma unroll
        for (int e = 0; e < 8; ++e) { S[e] = S[e] - keep * o[e] + v[e]; r[e] = S[e] * inv - v[e]; }
        *(u32x4*)(pb + (size_t)t * DM) = (u32x4){cvt_pk_bf16(r[0], r[1]), cvt_pk_bf16(r[2], r[3]), cvt_pk_bf16(r[4], r[5]), cvt_pk_bf16(r[6], r[7])}; }
}

__device__ __forceinline__ void lru_combine(float& A, float& H, float Ax, float Hx) { H = A * Hx + H; A = A * Ax; }
__device__ __forceinline__ void lru_phase(const Params& P, int l, LAS unsigned char* lds, bf16_t* ulru, int G, int c) {
    int tid = threadIdx.x; asm volatile("" : "+v"(tid));
    const int lane = tid & 63, wave = __builtin_amdgcn_readfirstlane(tid >> 6), l15 = lane & 15, q = lane >> 4;
    LAS float* XC = (LAS float*)lds;
    LAS bf16_t* XCB = (LAS bf16_t*)(lds + 65536);
    LAS float* GT = (LAS float*)(lds + 65536 + 36864);
    LAS bf16x8* WF = (LAS bf16x8*)(lds + 65536 + 36864 + 8192);
    const float* conv_w = P.in[6] + (size_t)l * 4 * DM; const float* conv_b = P.in[7] + (size_t)l * DM;
    const float* w_rg = P.in[8] + (size_t)l * 16 * 4096; const float* b_rg = P.in[9] + (size_t)l * DM;
    const float* w_ig = P.in[10] + (size_t)l * 16 * 4096; const float* b_ig = P.in[11] + (size_t)l * DM;
    const float* lam = P.in[12] + (size_t)l * DM;
    for (int it = c; it < BATCH * 16; it += G) {
        const int b = it >> 4, hb = it & 15, ch0 = hb * 64;
        const int chl = ch0 + lane;
        const float cw0 = conv_w[chl], cw1 = conv_w[DM + chl], cw2 = conv_w[2 * DM + chl], cw3 = conv_w[3 * DM + chl], cb = conv_b[chl];
        float brg[4], big[4], sp8[4], carry[4];
#pragma unroll
        for (int nt = 0; nt < 4; ++nt) { const int ch = ch0 + 16 * nt + l15; brg[nt] = b_rg[ch]; big[nt] = b_ig[ch]; carry[nt] = 0.f;
            const float x = -lam[ch]; sp8[nt] = -8.0f * (fmaxf(x, 0.f) + log1pf(__expf(-fabsf(x)))); }
        bf16_t* ubase = ulru + (size_t)b * SEQ * DM + ch0;
        __syncthreads();
#pragma unroll
        for (int k = 0; k < 4; ++k) { const int idx = tid * 4 + k * 2048;
            const f32x4 wv4 = *(const f32x4*)((idx < 4096 ? w_rg + (size_t)hb * 4096 + idx : w_ig + (size_t)hb * 4096 + (idx - 4096)));
            *(LAS f32x4*)(XC + idx) = wv4; }
        __syncthreads();
#pragma unroll
        for (int nt = 0; nt < 8; ++nt)
#pragma unroll
            for (int ks = 0; ks < 2; ++ks) { const LAS float* wsrc = XC + (nt < 4 ? 0 : 4096) + 16 * (nt & 3) + l15;
                const int k0 = ks * 32 + q * 8; unsigned pk[4];
#pragma unroll
                for (int e = 0; e < 4; ++e) pk[e] = cvt_pk_bf16(wsrc[(k0 + 2 * e) * 64], wsrc[(k0 + 2 * e + 1) * 64]);
                u32x4 t4 = (u32x4){pk[0], pk[1], pk[2], pk[3]};
                WF[(nt * 2 + ks) * 64 + lane] = __builtin_bit_cast(bf16x8, t4); }
        __syncthreads();
        unsigned short pre[35];
#pragma unroll
        for (int i = 0; i < 35; ++i) { const int t = 32 * wave - 3 + i; pre[i] = (t >= 0) ? ubase[(size_t)t * DM + lane] : (unsigned short)0; }
        for (int ck = 0; ck < SEQ / 256; ++ck) {
            const int t0 = ck * 256, par = ck & 1;
            { float uf[35];
#pragma unroll
                for (int i = 0; i < 35; ++i) uf[i] = __uint_as_float((unsigned)pre[i] << 16);
#pragma unroll
                for (int i = 0; i < 32; ++i) { const int t = 32 * wave + i; const float xc = cb + cw0 * uf[i] + cw1 * uf[i + 1] + cw2 * uf[i + 2] + cw3 * uf[i + 3];
                    XC[t * 64 + lane] = xc; XCB[t * 72 + lane] = (bf16_t)(cvt_pk_bf16(xc, 0.f) & 0xffffu); } }
            if (ck + 1 < SEQ / 256) {
#pragma unroll
                for (int i = 0; i < 35; ++i) pre[i] = ubase[(size_t)(t0 + 256 + 32 * wave - 3 + i) * DM + lane]; }
            asm volatile("s_waitcnt lgkmcnt(0)" ::: "memory");
            float Ac[2][4][4], Hl[2][4][4], EA[2][4], EH[2][4], TA0[4], TH0[4];
#pragma unroll
            for (int mt = 0; mt < 2; ++mt) {
                f32x4 ga[8];
                { float zf = 0.f; asm volatile("" : "+v"(zf));
#pragma unroll
                  for (int nt = 0; nt < 8; ++nt) ga[nt] = (f32x4){zf, zf, zf, zf}; }
#pragma unroll
                for (int ks = 0; ks < 2; ++ks) { const bf16x8 af = *(const LAS bf16x8*)(XCB + (wave * 32 + mt * 16 + l15) * 72 + ks * 32 + q * 8);
#pragma unroll
                    for (int nt = 0; nt < 8; ++nt) ga[nt] = __builtin_amdgcn_mfma_f32_16x16x32_bf16(af, WF[(nt * 2 + ks) * 64 + lane], ga[nt], 0, 0, 0); }
#pragma unroll
                for (int nt = 0; nt < 4; ++nt) {
                    float A = 1.f, H = 0.f;
#pragma unroll
                    for (int j = 0; j < 4; ++j) { const int t = wave * 32 + mt * 16 + 4 * q + j, ch = 16 * nt + l15;
                        const float r = fast_sigmoid(ga[nt][j] + brg[nt]), ig = fast_sigmoid(ga[nt + 4][j] + big[nt]);
                        const float log_a = r * sp8[nt]; const float a = __expf(log_a); const float x2 = 2.0f * log_a;
                        const float om = (x2 > -0.02f) ? (-x2 * (1.0f + x2 * (0.5f + x2 * (1.0f / 6.0f + x2 * (1.0f / 24.0f))))) : (1.0f - a * a);
                        const float bb = __builtin_amdgcn_sqrtf(om) * (ig * XC[t * 64 + ch]);
                        H = a * H + bb; A = a * A; Ac[mt][nt][j] = A; Hl[mt][nt][j] = H; }
                    { const float Ax = __shfl_up(A, 16), Hx = __shfl_up(H, 16); if (q >= 1) lru_combine(A, H, Ax, Hx); }
                    { const float Ax = __shfl_up(A, 32), Hx = __shfl_up(H, 32); if (q >= 2) lru_combine(A, H, Ax, Hx); }
                    { const float Ax = __shfl_up(A, 16), Hx = __shfl_up(H, 16); EA[mt][nt] = (q >= 1) ? Ax : 1.f; EH[mt][nt] = (q >= 1) ? Hx : 0.f; }
                    const float TA = __shfl(A, 48 + l15), TH = __shfl(H, 48 + l15);
                    if (mt == 0) { TA0[nt] = TA; TH0[nt] = TH; }
                    else { float WA = TA, WH = TH; lru_combine(WA, WH, TA0[nt], TH0[nt]);
                        if (q == 0) { GT[((par * 8 + wave) * 2 + 0) * 64 + 16 * nt + l15] = WA; GT[((par * 8 + wave) * 2 + 1) * 64 + 16 * nt + l15] = WH; } }
                }
            }
            asm volatile("s_waitcnt vmcnt(0) lgkmcnt(0)" ::: "memory");
            __syncthreads();
#pragma unroll
            for (int nt = 0; nt < 4; ++nt) { const int ch = 16 * nt + l15; float hin = carry[nt], hall = carry[nt];
#pragma unroll
                for (int g2 = 0; g2 < 8; ++g2) { const float ga2 = GT[((par * 8 + g2) * 2 + 0) * 64 + ch], gh2 = GT[((par * 8 + g2) * 2 + 1) * 64 + ch]; hall = ga2 * hall + gh2; if (g2 < wave) hin = hall; }
                carry[nt] = hall;
#pragma unroll
                for (int mt = 0; mt < 2; ++mt) { const float sin_mt = (mt == 0) ? hin : (TA0[nt] * hin + TH0[nt]); const float s = EA[mt][nt] * sin_mt + EH[mt][nt];
#pragma unroll
                    for (int j = 0; j < 4; ++j) { const float h = Ac[mt][nt][j] * s + Hl[mt][nt][j];
                        ubase[(size_t)(t0 + wave * 32 + mt * 16 + 4 * q + j) * DM + ch] = (bf16_t)(cvt_pk_bf16(h, 0.f) & 0xffffu); } } }
        }
    }
}

__device__ __forceinline__ void attn_phase(LAS unsigned char* lds, bf16_t* qn, const bf16_t* kn, const bf16_t* vT, int G, int c) {
    int tid = threadIdx.x; asm volatile("" : "+v"(tid));
    const int lane = tid & 63, w = __builtin_amdgcn_readfirstlane(tid >> 6), l31 = lane & 31, hi = lane >> 5;
    constexpr int KSTR = 272, VSTR = 72, KBYTES = 32 * KSTR, VBYTES = 128 * VSTR, WBYTES = KBYTES + VBYTES;
    LAS unsigned char* Kt = lds + w * WBYTES; LAS unsigned char* Vt = Kt + KBYTES;
    const float scale2 = 0.08838834764831845f * 1.4426950408889634f;
    constexpr int NITEM = BATCH * NH * (SEQ / 32);
    const int kst = (lane >> 4) * KSTR + (lane & 15) * 16, vst = (lane >> 2) * VSTR + (lane & 3) * 16;
    __syncthreads();
    for (int L = c * 8 + w; L < NITEM; L += G * 8) {
        const int qb = (SEQ / 32 - 1) - (L >> 7), bh = L & 127, b = bh >> 3, h = bh & 7;
        const size_t tokbase = (size_t)b * SEQ;
        const int qmin = qb * 32, qrow = qmin + l31;
        bf16x8 qf[8];
        { const bf16_t* qp = qn + (tokbase + qrow) * DM + h * HD + hi * 8;
#pragma unroll
            for (int ks = 0; ks < 8; ++ks) qf[ks] = *(const bf16x8*)(qp + ks * 16); }
        f32x16 O[4];
#pragma unroll
        for (int db = 0; db < 4; ++db)
#pragma unroll
            for (int e = 0; e < 16; ++e) O[db][e] = 0.f;
        float R = 0.f;
        const bf16_t* kbase = kn + tokbase * DM + h * HD + (size_t)(lane >> 4) * DM + (lane & 15) * 8;
        const bf16_t* vbase = vT + ((size_t)((b * NH + h) * HD) + (lane >> 2)) * SEQ + (lane & 3) * 8;
        u32x4 st[8];
#pragma unroll
        for (int i = 0; i < 8; ++i) st[i] = *(const u32x4*)(kbase + (size_t)(qb * 32 + 4 * i) * DM);
        for (int kt = qb; kt >= 0; --kt) {
            const int k0 = kt * 32;
            asm volatile("" ::: "memory");
#pragma unroll
            for (int i = 0; i < 8; ++i) *(LAS u32x4*)(Kt + kst + 4 * i * KSTR) = st[i];
#pragma unroll
            for (int i = 0; i < 8; ++i) st[i] = *(const u32x4*)(vbase + (size_t)(16 * i) * SEQ + k0);
            asm volatile("s_waitcnt lgkmcnt(0)" ::: "memory");
            f32x16 s, s1;
            { float zf = 0.f; asm volatile("" : "+v"(zf));
#pragma unroll
              for (int e = 0; e < 16; ++e) { s[e] = zf; s1[e] = zf; } }
            { bf16x8 kf[8];
#pragma unroll
              for (int ks = 0; ks < 8; ++ks) kf[ks] = *(const LAS bf16x8*)(Kt + l31 * KSTR + (ks * 16 + hi * 8) * 2);
              asm volatile("s_waitcnt lgkmcnt(0)" ::: "memory");
#pragma unroll
              for (int ks = 0; ks < 8; ks += 2) { s = __builtin_amdgcn_mfma_f32_32x32x16_bf16(kf[ks], qf[ks], s, 0, 0, 0);
                  s1 = __builtin_amdgcn_mfma_f32_32x32x16_bf16(kf[ks + 1], qf[ks + 1], s1, 0, 0, 0); } }
#pragma unroll
            for (int e = 0; e < 16; ++e) s[e] += s1[e];
            const bool diag = (kt == qb);
            float ls[16], lk[16];
#pragma unroll
            for (int e = 0; e < 16; ++e) { const float z = s[e] * scale2;
                const float sp = __builtin_amdgcn_logf(1.0f + __builtin_amdgcn_exp2f(-fabsf(z)));
                float lse = fminf(z, 0.f) - sp, lke = lse - z;
                if (diag) { const int key = k0 + 8 * (e >> 2) + 4 * hi + (e & 3); if (key >= qrow) { lke = 0.f; lse = -INFINITY; } }
                ls[e] = lse; lk[e] = lke; }
            float gs[4], gp[4];
#pragma unroll
            for (int bb = 0; bb < 4; ++bb) { gs[bb] = (lk[4 * bb] + lk[4 * bb + 1]) + (lk[4 * bb + 2] + lk[4 * bb + 3]); gp[bb] = __shfl_xor(gs[bb], 32); }
            float wv[16]; float E = R;
#pragma unroll
            for (int bb = 3; bb >= 0; --bb) { float base = hi ? E : E + gp[bb];
                wv[4 * bb + 3] = __builtin_amdgcn_exp2f(ls[4 * bb + 3] + base); base += lk[4 * bb + 3];
                wv[4 * bb + 2] = __builtin_amdgcn_exp2f(ls[4 * bb + 2] + base); base += lk[4 * bb + 2];
                wv[4 * bb + 1] = __builtin_amdgcn_exp2f(ls[4 * bb + 1] + base); base += lk[4 * bb + 1];
                wv[4 * bb + 0] = __builtin_amdgcn_exp2f(ls[4 * bb + 0] + base);
                E += gs[bb] + gp[bb]; }
            R = E;
            asm volatile("" ::: "memory");
#pragma unroll
            for (int i = 0; i < 8; ++i) { LAS unsigned char* d_ = Vt + vst + 16 * i * VSTR;
                *(LAS u32x2*)d_ = (u32x2){st[i].x, st[i].y}; *(LAS u32x2*)(d_ + 8) = (u32x2){st[i].z, st[i].w}; }
            if (kt > 0) {
#pragma unroll
                for (int i = 0; i < 8; ++i) st[i] = *(const u32x4*)(kbase + (size_t)(k0 - 32 + 4 * i) * DM); }
            asm volatile("s_waitcnt lgkmcnt(0)" ::: "memory");
            { u32x4 vb4[2][4];
#pragma unroll
              for (int p = 0; p < 2; ++p)
#pragma unroll
                for (int db = 0; db < 4; ++db) { const LAS unsigned char* vp = Vt + (32 * db + l31) * VSTR + (16 * p + 4 * hi) * 2;
                    const u32x2 v0 = *(const LAS u32x2*)vp, v1 = *(const LAS u32x2*)(vp + 16); vb4[p][db] = (u32x4){v0.x, v0.y, v1.x, v1.y}; }
              asm volatile("s_waitcnt lgkmcnt(0)" ::: "memory");
#pragma unroll
              for (int p = 0; p < 2; ++p) {
                u32x4 pa4 = (u32x4){cvt_pk_bf16(wv[8 * p], wv[8 * p + 1]), cvt_pk_bf16(wv[8 * p + 2], wv[8 * p + 3]), cvt_pk_bf16(wv[8 * p + 4], wv[8 * p + 5]), cvt_pk_bf16(wv[8 * p + 6], wv[8 * p + 7])};
                const bf16x8 pa = __builtin_bit_cast(bf16x8, pa4);
#pragma unroll
                for (int db = 0; db < 4; ++db) O[db] = __builtin_amdgcn_mfma_f32_32x32x16_bf16(pa, __builtin_bit_cast(bf16x8, vb4[p][db]), O[db], 0, 0, 0); } }
            if (__all(R < -150.8f)) break;
        }
#pragma unroll
        for (int db = 0; db < 4; ++db)
#pragma unroll
            for (int e = 0; e < 16; ++e) { const int q = qmin + 8 * (e >> 2) + 4 * hi + (e & 3);
                qn[(tokbase + q) * DM + h * HD + 32 * db + l31] = (bf16_t)(cvt_pk_bf16(O[db][e], 0.f) & 0xffffu); }
    }
}

#define XB_TMO      128
#define XB_XCNT(j)  (256  + 64 * (j))
#define XB_XSUB(j)  (1280 + 64 * (j))
#define XB_XGEN(j)  (2304 + 64 * (j))
#define XB_TOP      3328
#define XB_TOPGEN   3392
#define XCD_BAR_WORDS 3456
#define XB_SPIN_CAP (1u << 18)
__device__ __forceinline__ unsigned xb_ld(unsigned* p)              { return __hip_atomic_load(p, __ATOMIC_RELAXED, __HIP_MEMORY_SCOPE_AGENT); }
__device__ __forceinline__ unsigned xb_add(unsigned* p, unsigned v) { return __hip_atomic_fetch_add(p, v, __ATOMIC_RELAXED, __HIP_MEMORY_SCOPE_AGENT); }
__device__ __forceinline__ unsigned xb_xcc_id() { return (unsigned)__builtin_amdgcn_s_getreg((3 << 11) | 20) & 0xFu; }
#define XB_SPIN(cond, bar) do { unsigned _sp = 0; while (cond) { __builtin_amdgcn_s_sleep(1); \
    if ((++_sp & 255u) == 0u) { if (xb_ld(&(bar)[XB_TMO])) break; if (_sp > XB_SPIN_CAP) { atomicAdd(&(bar)[XB_TMO], 1u); break; } } } } while (0)
struct XcdBarrier { unsigned* bar; unsigned x; volatile LAS unsigned* st; };
__device__ __forceinline__ XcdBarrier xcd_barrier_post(unsigned* bar, volatile LAS unsigned* st) {
    XcdBarrier b; b.bar = bar; b.x = xb_xcc_id(); b.st = st;
    if (threadIdx.x == 0) st[2] = xb_add(&bar[XB_XCNT(b.x)], 1u);
    return b;
}
__device__ __forceinline__ void xcd_barrier_complete(unsigned* bar, unsigned x, unsigned& nloc, unsigned& nx) {
    const unsigned G = gridDim.x * gridDim.y * gridDim.z;
    unsigned sum, cnt, mine, sp = 0u;
    for (;;) {
        sum = 0u; cnt = 0u; mine = 0u;
#pragma unroll
        for (unsigned j = 0; j < 16; ++j) { const unsigned c = xb_ld(&bar[XB_XCNT(j)]); sum += c; cnt += (c > 0u) ? 1u : 0u; mine = (j == x) ? c : mine; }
        if (sum == G) break;
        __builtin_amdgcn_s_sleep(1);
        if ((++sp & 255u) == 0u) { if (xb_ld(&bar[XB_TMO])) break; if (sp > XB_SPIN_CAP) { atomicAdd(&bar[XB_TMO], 1u); break; } }
    }
    nloc = mine > 0u ? mine : 1u; nx = cnt > 0u ? cnt : 1u;
}
__device__ __forceinline__ void xcd_barrier(const XcdBarrier& b) {
    asm volatile("s_waitcnt vmcnt(0)" ::: "memory");
    __syncthreads();
    if (threadIdx.x == 0) {
        unsigned* bar = b.bar; asm volatile("" : "+s"(bar));
        __builtin_amdgcn_s_waitcnt(0);
        unsigned nloc = b.st[0], nx = b.st[1];
        if (nloc == 0u) { xcd_barrier_complete(bar, b.x, nloc, nx); b.st[0] = nloc; b.st[1] = nx; }
        const unsigned old = xb_add(&bar[XB_XSUB(b.x)], 1u);
        const unsigned gen = old / nloc;
        if (old + 1u == (gen + 1u) * nloc) {
            __builtin_amdgcn_fence(__ATOMIC_RELEASE, "agent");
            asm volatile("s_waitcnt vmcnt(0)" ::: "memory");
            const unsigned og = xb_add(&bar[XB_TOP], 1u);
            const unsigned tg = og / nx;
            if (og + 1u == (tg + 1u) * nx) xb_add(&bar[XB_TOPGEN], 1u);
            else XB_SPIN(xb_ld(&bar[XB_TOPGEN]) == tg, bar);
            __builtin_amdgcn_fence(__ATOMIC_ACQUIRE, "agent");
            xb_add(&bar[XB_XGEN(b.x)], 1u);
            asm volatile("s_waitcnt vmcnt(0)" ::: "memory");
        } else {
            XB_SPIN(xb_ld(&bar[XB_XGEN(b.x)]) == gen, bar);
            __builtin_amdgcn_fence(__ATOMIC_ACQUIRE, "agent");
            asm volatile("s_waitcnt vmcnt(0)" ::: "memory");
        }
    }
    __syncthreads();
}

__global__ void __launch_bounds__(512, 2) mega(Params P) {
    extern __shared__ __attribute__((aligned(16))) unsigned char lds_raw[];
    LAS unsigned char* lds = (LAS unsigned char*)lds_raw;
    cg::grid_group grid = cg::this_grid();
    const int G = gridDim.x; int c = blockIdx.x;
    volatile LAS unsigned* bst = (volatile LAS unsigned*)(lds + LDS_BYTES - 64);
    if (threadIdx.x < 2) bst[threadIdx.x] = 0u;
    __syncthreads();
    const XcdBarrier xbar = xcd_barrier_post((unsigned*)(P.ws + WS_CTL), bst);
#define WSL() unsigned char* wsl = P.ws; asm volatile("" : "+s"(wsl))
#define s0 ((bf16_t*)(wsl + SLOT0))
#define s1 (s0 + SLOT_ELEMS)
#define s2 (s0 + 2 * SLOT_ELEMS)
#define s3 (s0 + 3 * SLOT_ELEMS)
#define s4 (s0 + 4 * SLOT_ELEMS)
#define s5 (s0 + 5 * SLOT_ELEMS)
#define s6 (s0 + 6 * SLOT_ELEMS)
#define Win ((const bf16_t*)(wsl + W_IN))
#define Wpool ((const bf16_t*)(wsl + W_POOL))
#define Wbr ((const bf16_t*)(wsl + W_BR))
#define Wout ((const bf16_t*)(wsl + W_OUT))
#define Wgu ((const bf16_t*)(wsl + W_GU))
#define Wdown ((const bf16_t*)(wsl + W_DOWN))
    const int lo = P.lo, hi = P.hi;
#define IN(k) (lo <= (k) && (k) < hi)
#ifndef PROBE_MASK
#define PROBE_MASK 0
#endif
#define PB(k) unsigned long long pt0_ = 0; if ((PROBE_MASK >> (k)) & 1) pt0_ = __builtin_amdgcn_s_memrealtime()
#define PE(k) do { if ((PROBE_MASK >> (k)) & 1) { const unsigned long long pt1_ = __builtin_amdgcn_s_memrealtime(); while (__builtin_amdgcn_s_memrealtime() - pt1_ < pt1_ - pt0_) __builtin_amdgcn_s_sleep(8); } } while (0)
#define SEAM(k) do { if (IN(k) && IN((k) + 1)) { PB(10); \
        if ((k) == 0) { xcd_barrier(xbar);     \
              \
            if (threadIdx.x == 0) { unsigned* bw_ = (unsigned*)(P.ws + WS_CTL); bool ok_ = (G % 8) == 0; \
                for (int j_ = 0; j_ < 16; ++j_) { const unsigned n_ = xb_ld(&bw_[XB_XCNT(j_)]); ok_ = ok_ && (n_ == (j_ < 8 ? (unsigned)(G / 8) : 0u)); } \
                bst[3] = ok_ ? (bst[2] * 8u + xbar.x) : (unsigned)blockIdx.x; } \
            __syncthreads(); c = (int)bst[3]; } \
        else xcd_barrier(xbar); PE(10); } } while (0)
    for (int l = 0; l < NLAYER; ++l) {
        const int pb = l * 10;
        int tid = threadIdx.x; asm volatile("" : "+v"(tid));
        const int lane = tid & 63, wave = __builtin_amdgcn_readfirstlane(tid >> 6);
        const int gw = c * 8 + wave, NGW = G * 8, gtid = c * 512 + tid, NT = G * 512;
        const float* xin = (l == 0) ? P.in[0] : P.out;
        if (IN(pb + 0)) {
            PB(0); WSL();
            convert_weights(P, l, lds, gw, NGW, wave, lane);
            rms_rows(xin, P.in[1] + (size_t)l * DM, s0, gw, NGW, lane);
            PE(0);
        }
        SEAM(pb + 0);
        if (IN(pb + 1)) {
            PB(1); WSL();
            using C1 = pg8::Cfg<MTOK, 5120, DM, DM, DM>;
            pg8::EpiInProj E{s1, s5, (LAS float*)(lds + 131072 + 1024), P.in[13] + (size_t)l * HD, P.in[14] + (size_t)l * HD};
            pg8::gemm_phase<C1>(lds, s0, Win, G, c, E);
            PE(1);
        }
        SEAM(pb + 1);
        if (IN(pb + 2)) {
            PB(2); WSL();
            lru_phase(P, l, lds, s2, G, c);
            { using C2 = pg8::Cfg<MTOK, DM, 256, DM, 256, 1, 256>;
              int tid2 = threadIdx.x; asm volatile("" : "+v"(tid2));
              pg8::Unit uu;
              for (int i = 0; pg8::next_unit<C2>(i, G, c, uu); ++i) pool_tile(s6, s1, uu.pm, uu.pn, tid2);
              __syncthreads();
              using CW = pg8::Cfg<DM, DM, 256, DM, 256, 1, 256>;
              pg8::EpiColOp<2> E{(bf16_t*)(wsl + W_EFF), DM, nullptr};
              pg8::gemm_phase<CW>(lds, Wbr, Wpool, G, c, E); }
            attn_phase(lds, s3, s4, s5, G, c);
            PE(2);
        }
        SEAM(pb + 2);
        if (IN(pb + 4)) {
            PB(4); WSL();
            pg8::EpiGateMerge E{s4 + (size_t)c * 131072, s6 + (size_t)c * 65536, s5, P.in[3] + (size_t)l * 3 * DM};
            pg8::gemm_phase<pg8::CfgGM>(lds, s0, (const bf16_t*)wsl, G, c, E);
            PE(4);
        }
        SEAM(pb + 4);
        if (IN(pb + 6)) {
            PB(6); WSL();
            using C5 = pg8::CfgPair<DM, DM>;
            pg8::EpiResid E{xin, P.out};
            pg8::gemm_phase<C5>(lds, s5, Wout, G, c, E);
            PE(6);
        }
        SEAM(pb + 6);
        if (IN(pb + 7)) { PB(7); WSL(); rms_rows(P.out, P.in[17] + (size_t)l * DM, s0, gw, NGW, lane); PE(7); }
        SEAM(pb + 7);
        if (IN(pb + 8)) {
            PB(8); WSL();
            using C6 = pg8::Cfg<MTOK, NGU, DM, DM, DM>;
            pg8::EpiSwiglu E{s3};
            pg8::gemm_phase<C6>(lds, s0, Wgu, G, c, E);
            PE(8);
        }
        SEAM(pb + 8);
        if (IN(pb + 9)) {
            PB(9); WSL();
            using C7 = pg8::CfgPair<DFF, DFF>;
            pg8::EpiResid E{P.out, P.out};
            pg8::gemm_phase<C7>(lds, s3, Wdown, G, c, E);
            PE(9);
        }
        SEAM(pb + 9);
    }
    if (P.dbg >= 0) {
        asm volatile("s_waitcnt vmcnt(0) lgkmcnt(0)" ::: "memory"); grid.sync(); __builtin_amdgcn_fence(__ATOMIC_ACQUIRE, "agent"); asm volatile("s_waitcnt vmcnt(0)" ::: "memory");
        WSL(); const bf16_t* sl = s0 + (size_t)P.dbg * SLOT_ELEMS;
        for (size_t i = (size_t)c * 512 + threadIdx.x; i < (size_t)MTOK * DM; i += (size_t)G * 512) { float v = __uint_as_float((unsigned)sl[i] << 16) + DBG_ADD; if (!(fabsf(v) < 1e30f)) v = 12345.0f; P.out[i] = v; }
    }
#undef IN
#undef SEAM
#undef s0
#undef s1
#undef s2
#undef s3
#undef s4
#undef s5
#undef s6
#undef Win
#undef Wpool
#undef Wbr
#undef Wout
#undef Wgu
#undef Wdown
}

extern "C" void kernel_launch(void* const* d_in, const int* in_sizes, int n_in, void* d_out, int out_size, void* d_ws, size_t ws_size, hipStream_t stream) {
    static int grid = 0;
    if (grid == 0) {
        if (n_in != 21 || ws_size < WS_NEED) { fprintf(stderr, "kernel_launch: unexpected n_in %d / ws_size %zu (need %zu)\n", n_in, ws_size, (size_t)WS_NEED); grid = -1; return; }
        int dev = 0, cus = 0, per_cu = 0;
        hipGetDevice(&dev); hipDeviceGetAttribute(&cus, hipDeviceAttributeMultiprocessorCount, dev);
        if (hipFuncSetAttribute((const void*)mega, hipFuncAttributeMaxDynamicSharedMemorySize, LDS_BYTES) != hipSuccess) { fprintf(stderr, "kernel_launch: hipFuncSetAttribute failed\n"); grid = -1; return; }
        if (hipOccupancyMaxActiveBlocksPerMultiprocessor(&per_cu, (const void*)mega, 512, LDS_BYTES) != hipSuccess || per_cu < 1) { fprintf(stderr, "kernel_launch: occupancy query gave %d\n", per_cu); per_cu = 1; }
        (void)hipGetLastError();
        grid = cus * per_cu;
    }
    if (grid < 0) return;
    if (hipMemsetAsync((char*)d_ws + WS_CTL, 0, CTL_BYTES, stream) != hipSuccess) { fprintf(stderr, "kernel_launch: memset failed\n"); return; }
    Params p{};
    for (int i = 0; i < 21; ++i) p.in[i] = (const float*)d_in[i];
    p.out = (float*)d_out; p.ws = (unsigned char*)d_ws; p.lo = 0; p.hi = DBG_HI; p.dbg = DBG_SLOT;
    void* args[] = {&p};
    hipError_t e = hipLaunchCooperativeKernel((const void*)mega, dim3(grid), dim3(512), args, LDS_BYTES, stream);
    if (e != hipSuccess) fprintf(stderr, "cooperative launch failed: %s (grid %d)\n", hipGetErrorString(e), grid);
}
```

```cpp
#include <hip/hip_runtime.h>
#include <hip/hip_cooperative_groups.h>
#include <cstdio>
#include <cstdint>
namespace cg = cooperative_groups;

#define LAS __attribute__((address_space(3)))
typedef unsigned short bf16_t;
typedef short bf16x8 __attribute__((ext_vector_type(8)));
typedef float f32x4 __attribute__((ext_vector_type(4)));
typedef float f32x16 __attribute__((ext_vector_type(16)));
typedef unsigned u32x4 __attribute__((ext_vector_type(4)));
typedef unsigned u32x2 __attribute__((ext_vector_type(2)));

constexpr int BATCH = 16, SEQ = 2048, DM = 1024, MTOK = BATCH * SEQ, NH = 8, HD = 128, DFF = 2816, NGU = 2 * DFF, NLAYER = 2;
constexpr float EPS = 1e-6f;
#ifndef DBG_HI
#define DBG_HI 20
#define DBG_ADD 0.f
#define DBG_SLOT (-1)
#define DBG_OUT_OFF 0
#endif
constexpr size_t MiB = 1u << 20;
constexpr size_t SLOT_BYTES = 64 * MiB, SLOT_ELEMS = SLOT_BYTES / 2;
constexpr size_t W_IN = 0, W_POOL = 16 * MiB, W_BR = W_POOL + MiB / 2, W_OUT = W_BR + 6 * MiB, W_GU = W_OUT + 2 * MiB, W_DOWN = W_GU + 11 * MiB;
constexpr size_t SLOT0 = 42 * MiB;
static_assert(W_DOWN + (size_t)DM * DFF * 2 <= SLOT0, "weight map");
constexpr size_t WS_CTL = SLOT0 + 7 * SLOT_BYTES;
constexpr size_t CTL_BYTES = 16384;
constexpr size_t W_EFF = WS_CTL + 1 * MiB;
constexpr size_t WS_NEED = W_EFF + 2 * MiB;
constexpr int LDS_BYTES = 147456;

typedef __bf16 bf16v2_t __attribute__((ext_vector_type(2)));
typedef float f32v2_t __attribute__((ext_vector_type(2)));
__device__ __forceinline__ unsigned cvt_pk_bf16(float lo, float hi) { const f32v2_t f = {lo, hi}; const bf16v2_t v = __builtin_convertvector(f, bf16v2_t); return __builtin_bit_cast(unsigned, v); }
__device__ __forceinline__ float bf_lo(unsigned u) { return __uint_as_float(u << 16); }
__device__ __forceinline__ float bf_hi(unsigned u) { return __uint_as_float(u & 0xffff0000u); }
__device__ __forceinline__ float fast_sigmoid(float x) { return __builtin_amdgcn_rcpf(1.0f + __expf(-x)); }
__device__ __forceinline__ float wave_sum(float v) {
#pragma unroll
    for (int o = 1; o < 64; o <<= 1) v += __shfl_xor(v, o);
    return v;
}

namespace pg8 {
constexpr int BM = 256, BK = 64, HALF = 128, HTB = HALF * BK * 2, STAGE_BYTES = 8 * HTB, NXCD = 8, WGM = 4;
__host__ __device__ __forceinline__ int lds_byte(int r, int c) { const int st = (r >> 4) * 2 + (c >> 5), rr = r & 15, cc = c & 31, ob = rr * 64 + cc * 2; return st * 1024 + (ob ^ (((ob >> 9) & 1) << 5)); }
__host__ __device__ __forceinline__ void stage_rc(int b, int& R, int& C) { const int st = b / 1024, sb = b % 1024, swz = sb ^ (((sb >> 9) & 1) << 5); R = (st >> 1) * 16 + swz / 64; C = (st & 1) * 32 + (swz % 64) / 2; }
__host__ __device__ __forceinline__ int perm32(int rho) { const int n = rho >> 4, i = rho & 15; return 8 * (i >> 2) + 4 * n + (i & 3); }

struct Unit { int pm, pn, z; };
template <int M_, int N_, int K_, int LDA_, int LDB_, int NZ_ = 1, int APN_ = 0, long AZ_ = 0, long BZ_ = 0>
struct Cfg { static constexpr int nM = M_ / BM, nN = N_ / BM, nwg = nM * nN, K = K_, LDA = LDA_, LDB = LDB_, NZ = NZ_, APN = APN_; static constexpr long AZ = AZ_, BZ = BZ_;
    static __device__ __forceinline__ size_t aoff(const Unit& u) { return (size_t)u.z * AZ + (size_t)u.pm * (BM * LDA) + (size_t)u.pn * APN; }
    static __device__ __forceinline__ size_t boff(const Unit& u) { return (size_t)u.z * BZ + (size_t)u.pn * (BM * LDB); }
    static __device__ __forceinline__ void fix(Unit&) {} };
struct CfgGM { static constexpr int nM = MTOK / BM, nN = DM / BM, nwg = nM * nN, K = DM, LDA = DM, LDB = DM, NZ = 6;
    static __device__ __forceinline__ void fix(Unit& u) { const int z6 = u.z; u.z = (z6 < 3) ? 2 * z6 : 2 * (z6 - 3) + 1; }
    static __device__ __forceinline__ size_t aoff(const Unit& u) { return ((u.z & 1) ? (size_t)(1 + (u.z >> 1)) * SLOT_ELEMS : (size_t)0) + (size_t)u.pm * (BM * DM); }
    static __device__ __forceinline__ size_t boff(const Unit& u) { return ((u.z & 1) ? ((u.z == 1) ? (size_t)(W_EFF / 2) : (size_t)(W_BR / 2) + (size_t)(u.z >> 1) * DM * DM) : (size_t)(5120 + (u.z >> 1) * DM) * DM) + (size_t)u.pn * (BM * DM); } };
template <class C>
__device__ __forceinline__ bool next_unit(int i, int G, int c, Unit& u) {
    const int round = i / C::NZ; u.z = i - round * C::NZ;
    const int L = round * G + c; if (L >= C::nwg) return false;
    int wgid = L; { constexpr int q = C::nwg / NXCD, r = C::nwg % NXCD; const int xcd = wgid % NXCD, off = wgid / NXCD; wgid = (xcd < r ? xcd * (q + 1) : r * (q + 1) + (xcd - r) * q) + off; }
    constexpr int nig = WGM * C::nN; const int gid = wgid / nig, fm = gid * WGM, gsz = (C::nM - fm) < WGM ? (C::nM - fm) : WGM;
    u.pm = fm + ((wgid % nig) % gsz); u.pn = (wgid % nig) / gsz; C::fix(u); return true;
}

template <class C, class Epi>
__device__ __forceinline__ void gemm_phase(LAS unsigned char* lds, const bf16_t* gA, const bf16_t* gBt, const int G, const int c, const Epi& E) {
    int tid = threadIdx.x; asm volatile("" : "+v"(tid));
    const int wid = __builtin_amdgcn_readfirstlane(tid >> 6), lane = tid & 63, wr = wid >> 2, wc = wid & 3, fr = lane & 15, fq = lane >> 4;
    constexpr int nt = C::K / BK;
    unsigned voffA[2], voffB[2];
#pragma unroll
    for (int i = 0; i < 2; ++i) { int R, Cc; stage_rc(tid * 16 + i * 8192, R, Cc); const int Rb = Epi::PERM ? ((R & ~31) + perm32(R & 31)) : R;
        voffA[i] = (unsigned)(R * C::LDA + Cc) * 2u; voffB[i] = (unsigned)(Rb * C::LDB + Cc) * 2u; }
    constexpr unsigned kstep = BK * 2;
    constexpr unsigned hstepA = HALF * C::LDA * 2, hstepB = HALF * C::LDB * 2;
    const unsigned ldsw = (unsigned)wid * 1024u;
    const int aoff = lds_byte(wr * 64 + fr, fq * 8), boff = lds_byte(wc * 32 + fr, fq * 8);
#define PG8_APTR(u) ((const char*)gA + C::aoff(u) * 2)
#define PG8_BPTR(u) ((const char*)gBt + C::boff(u) * 2)
#define PG8_SA(b, h) (((b) * 2 + (h)) * HTB)
#define PG8_SB(b, h) ((4 + (b) * 2 + (h)) * HTB)
#define PG8_STAGE(bufoff, gbase, voff) do { _Pragma("unroll") for (int _i = 0; _i < 2; ++_i) \
        __builtin_amdgcn_global_load_lds((const unsigned*)((const char*)(gbase) + (voff)[_i]), (LAS unsigned*)(lds + (bufoff) + ldsw + _i * 8192), 16, 0, 0); } while (0)
#define PG8_LDA(dst, b, h) do { _Pragma("unroll") for (int m = 0; m < 4; ++m) _Pragma("unroll") for (int k = 0; k < 2; ++k) dst[m][k] = *(const LAS bf16x8*)(lds + PG8_SA(b, h) + aoff + m * 2048 + k * 1024); } while (0)
#define PG8_LDB(dst, b, h) do { _Pragma("unroll") for (int n = 0; n < 2; ++n) _Pragma("unroll") for (int k = 0; k < 2; ++k) dst[n][k] = *(const LAS bf16x8*)(lds + PG8_SB(b, h) + boff + n * 2048 + k * 1024); } while (0)
#define PG8_MMA(ai, bj, At, Bt) do { __builtin_amdgcn_s_setprio(1); _Pragma("unroll") for (int m = 0; m < 4; ++m) _Pragma("unroll") for (int n = 0; n < 2; ++n) _Pragma("unroll") for (int k = 0; k < 2; ++k) \
        acc[ai][bj][m][n] = __builtin_amdgcn_mfma_f32_16x16x32_bf16(Bt[n][k], At[m][k], acc[ai][bj][m][n], 0, 0, 0); __builtin_amdgcn_s_setprio(0); } while (0)
#define PG8_WAIT_V(n) asm volatile("s_waitcnt vmcnt(" #n ")" ::: "memory")
#define PG8_WAIT_L(n) asm volatile("s_waitcnt lgkmcnt(" #n ")" ::: "memory")
#define PG8_BAR __builtin_amdgcn_s_barrier()
#define PG8_SCHED __builtin_amdgcn_sched_barrier(0)
    Unit cur, nxt; int ui = 0;
    if (!next_unit<C>(0, G, c, cur)) return;
    f32x4 acc[2][2][4][2];
#pragma unroll
    for (int a = 0; a < 2; ++a)
#pragma unroll
        for (int b = 0; b < 2; ++b)
#pragma unroll
            for (int m = 0; m < 4; ++m)
#pragma unroll
                for (int n = 0; n < 2; ++n) acc[a][b][m][n] = (f32x4){0.f, 0.f, 0.f, 0.f};
    bf16x8 At[4][2], B0[2][2], B1[2][2];
    const char* cA = PG8_APTR(cur); const char* cB = PG8_BPTR(cur);
    PG8_STAGE(PG8_SB(0, 0), cB, voffB); PG8_STAGE(PG8_SB(0, 1), cB + hstepB, voffB); PG8_STAGE(PG8_SA(0, 0), cA, voffA); PG8_STAGE(PG8_SA(0, 1), cA + hstepA, voffA);
    if (wr == 1) PG8_BAR;
    PG8_WAIT_V(2); PG8_BAR;
    PG8_STAGE(PG8_SB(1, 0), cB + kstep, voffB); PG8_STAGE(PG8_SA(1, 0), cA + kstep, voffA); PG8_STAGE(PG8_SB(1, 1), cB + hstepB + kstep, voffB);
    PG8_WAIT_V(6); PG8_BAR;
    for (;;) {
        const bool has_next = next_unit<C>(ui + 1, G, c, nxt);
        const char* nA = has_next ? PG8_APTR(nxt) : cA; const char* nB = has_next ? PG8_BPTR(nxt) : cB;
#pragma nounroll
        for (int t = 0; t < nt; t += 2) {
            const bool last = (t == nt - 2);
            const char* a1 = cA + (t + 1) * kstep;
            const char* a2 = last ? nA : cA + (t + 2) * kstep; const char* b2 = last ? nB : cB + (t + 2) * kstep;
            const char* a3 = a2 + kstep; const char* b3 = b2 + kstep;
            PG8_LDB(B0, 0, 0); PG8_LDB(B1, 0, 1); PG8_SCHED; PG8_LDA(At, 0, 0); PG8_STAGE(PG8_SA(1, 1), a1 + hstepA, voffA);
            PG8_WAIT_V(8); PG8_WAIT_L(0); PG8_BAR; PG8_MMA(0, 0, At, B0); PG8_MMA(0, 1, At, B1); PG8_BAR; PG8_SCHED;
            PG8_LDA(At, 0, 1); PG8_STAGE(PG8_SB(0, 0), b2, voffB); PG8_STAGE(PG8_SB(0, 1), b2 + hstepB, voffB); PG8_STAGE(PG8_SA(0, 0), a2, voffA);
            PG8_WAIT_V(8); PG8_WAIT_L(0); PG8_BAR; PG8_MMA(1, 0, At, B0); PG8_MMA(1, 1, At, B1); PG8_BAR; PG8_SCHED;
            PG8_LDB(B0, 1, 0); PG8_LDB(B1, 1, 1); PG8_SCHED; PG8_LDA(At, 1, 0); PG8_STAGE(PG8_SA(0, 1), a2 + hstepA, voffA);
            PG8_WAIT_V(8); PG8_WAIT_L(0); PG8_BAR; PG8_MMA(0, 0, At, B0); PG8_MMA(0, 1, At, B1); PG8_BAR; PG8_SCHED;
            PG8_LDA(At, 1, 1); PG8_STAGE(PG8_SB(1, 0), b3, voffB); PG8_STAGE(PG8_SB(1, 1), b3 + hstepB, voffB); PG8_STAGE(PG8_SA(1, 0), a3, voffA);
            PG8_WAIT_V(8); PG8_WAIT_L(0); PG8_BAR; PG8_MMA(1, 0, At, B0); PG8_MMA(1, 1, At, B1); PG8_BAR; PG8_SCHED;
        }
        if (wr == 0) PG8_BAR;
        E(acc, cur, wr, wc, fr, fq);
        if (!has_next) break;
#pragma unroll
        for (int a = 0; a < 2; ++a)
#pragma unroll
            for (int b = 0; b < 2; ++b)
#pragma unroll
                for (int m = 0; m < 4; ++m)
#pragma unroll
                    for (int n = 0; n < 2; ++n) acc[a][b][m][n] = (f32x4){0.f, 0.f, 0.f, 0.f};
        cur = nxt; cA = nA; cB = nB; ++ui;
        if (wr == 1) PG8_BAR;
    }
    PG8_WAIT_V(0);
    PG8_BAR;
#undef PG8_APTR
#undef PG8_BPTR
#undef PG8_SA
#undef PG8_SB
#undef PG8_STAGE
#undef PG8_LDA
#undef PG8_LDB
#undef PG8_MMA
#undef PG8_WAIT_V
#undef PG8_WAIT_L
#undef PG8_BAR
#undef PG8_SCHED
}

typedef f32x4 Acc[2][2][4][2];

struct EpiInProj {
    static constexpr bool PERM = true;
    bf16_t* base; bf16_t* vT; LAS float* X; const float* qg; const float* kg;
    __device__ __forceinline__ void operator()(const Acc& acc, const Unit& u, int wr, int wc, int fr, int fq) const {
        asm volatile("" : "+v"(fr), "+v"(fq));
        const int row0 = u.pm * BM + wr * 64 + fr;
        if (u.pn >= 8 && u.pn < 16) {
            bf16_t* dst = base + (size_t)(u.pn >> 2) * SLOT_ELEMS; const int col0 = (u.pn & 3) * 256 + wc * 32 + 8 * fq;
#pragma unroll
            for (int ai = 0; ai < 2; ++ai)
#pragma unroll
                for (int m = 0; m < 4; ++m)
#pragma unroll
                    for (int bj = 0; bj < 2; ++bj) { const f32x4 v0 = acc[ai][bj][m][0], v1 = acc[ai][bj][m][1];
                        float s = ((v0[0] * v0[0] + v0[1] * v0[1]) + (v0[2] * v0[2] + v0[3] * v0[3])) + ((v1[0] * v1[0] + v1[1] * v1[1]) + (v1[2] * v1[2] + v1[3] * v1[3]));
                        s += __shfl_xor(s, 16); s += __shfl_xor(s, 32);
                        if (fq == 0) X[((wr * 4 + wc) * 16 + (ai * 4 + m) * 2 + bj) * 16 + fr] = s; asm volatile("" ::: "memory"); }
            asm volatile("s_waitcnt lgkmcnt(0)" ::: "memory"); __builtin_amdgcn_s_barrier(); asm volatile("" ::: "memory");
            const float* gsrc = ((u.pn < 12) ? qg : kg) + wc * 32 + 8 * fq;
            const f32x4 g0 = *(const f32x4*)gsrc, g1 = *(const f32x4*)(gsrc + 4);
#pragma unroll
            for (int ai = 0; ai < 2; ++ai)
#pragma unroll
                for (int m = 0; m < 4; ++m) { bf16_t* rowp = dst + (size_t)(row0 + ai * HALF + m * 16) * DM + col0;
#pragma unroll
                    for (int bj = 0; bj < 2; ++bj) { const int xi = ((ai * 4 + m) * 2 + bj) * 16 + fr;
                        const float tot = (X[(wr * 4 + 0) * 256 + xi] + X[(wr * 4 + 1) * 256 + xi]) + (X[(wr * 4 + 2) * 256 + xi] + X[(wr * 4 + 3) * 256 + xi]);
                        const float rstd = rsqrtf(tot * (1.f / HD) + EPS);
                        const f32x4 v0 = acc[ai][bj][m][0] * rstd * g0, v1 = acc[ai][bj][m][1] * rstd * g1; u32x4 w;
                        w.x = cvt_pk_bf16(v0[0], v0[1]); w.y = cvt_pk_bf16(v0[2], v0[3]); w.z = cvt_pk_bf16(v1[0], v1[1]); w.w = cvt_pk_bf16(v1[2], v1[3]);
                        *(u32x4*)(rowp + bj * HALF) = w; asm volatile("" ::: "memory"); } }
        } else if (u.pn < 8) {
            bf16_t* dst = base + (size_t)((u.pn >> 2) ? 1 : 5) * SLOT_ELEMS; const int col0 = (u.pn & 3) * 256 + wc * 32 + 8 * fq;
#pragma unroll
            for (int ai = 0; ai < 2; ++ai)
#pragma unroll
                for (int m = 0; m < 4; ++m) { bf16_t* rowp = dst + (size_t)(row0 + ai * HALF + m * 16) * DM + col0;
#pragma unroll
                    for (int bj = 0; bj < 2; ++bj) { const f32x4 v0 = acc[ai][bj][m][0], v1 = acc[ai][bj][m][1]; u32x4 w;
                        w.x = cvt_pk_bf16(v0[0], v0[1]); w.y = cvt_pk_bf16(v0[2], v0[3]); w.z = cvt_pk_bf16(v1[0], v1[1]); w.w = cvt_pk_bf16(v1[2], v1[3]);
                        *(u32x4*)(rowp + bj * HALF) = w; } }
        } else {
            LAS unsigned char* Wb = (LAS unsigned char*)X + (wr * 4 + wc) * 1024;
            const int lane_ = fq * 16 + fr, dr = lane_ >> 1, hf = lane_ & 1;
#pragma unroll
            for (int ai = 0; ai < 2; ++ai)
#pragma unroll
                for (int m = 0; m < 4; ++m) { const int rowb = u.pm * BM + wr * 64 + ai * HALF + m * 16; const int b = rowb >> 11, s0 = rowb & 2047;
#pragma unroll
                    for (int bj = 0; bj < 2; ++bj) { const int head = (u.pn - 16) * 2 + bj;
                        asm volatile("" ::: "memory");
#pragma unroll
                        for (int n = 0; n < 2; ++n) { const f32x4 v = acc[ai][bj][m][n];
                            const unsigned w0 = cvt_pk_bf16(v[0], v[1]), w1 = cvt_pk_bf16(v[2], v[3]);
                            LAS unsigned short* wp = (LAS unsigned short*)(Wb + (8 * fq + 4 * n) * 32 + fr * 2);
                            wp[0] = (unsigned short)(w0 & 0xffffu); wp[16] = (unsigned short)(w0 >> 16); wp[32] = (unsigned short)(w1 & 0xffffu); wp[48] = (unsigned short)(w1 >> 16); }
                        asm volatile("s_waitcnt lgkmcnt(0)" ::: "memory");
                        const u32x4 t4 = *(const LAS u32x4*)(Wb + dr * 32 + hf * 16);
                        *(u32x4*)(vT + ((size_t)((b * NH + head) * HD + wc * 32 + dr)) * SEQ + s0 + hf * 8) = t4;
                        asm volatile("s_waitcnt lgkmcnt(0)" ::: "memory"); } }
        }
    }
};
template <int MODE> struct EpiColOp {
    static constexpr bool PERM = true;
    bf16_t* O; int ldc; const float* vec;
    __device__ __forceinline__ void operator()(const Acc& acc, const Unit& u, int wr, int wc, int fr, int fq) const {
        const int row0 = u.pm * BM + wr * 64 + fr, col0 = u.pn * BM + wc * 32 + 8 * fq;
        f32x4 bv[2][2];
#pragma unroll
        for (int bj = 0; bj < 2; ++bj)
#pragma unroll
            for (int n = 0; n < 2; ++n) bv[bj][n] = (MODE == 2) ? (f32x4){1.f, 1.f, 1.f, 1.f} : *(const f32x4*)(vec + col0 + bj * HALF + 4 * n);
#pragma unroll
        for (int ai = 0; ai < 2; ++ai)
#pragma unroll
            for (int m = 0; m < 4; ++m) { bf16_t* rowp = O + (size_t)(row0 + ai * HALF + m * 16) * ldc + col0;
#pragma unroll
                for (int bj = 0; bj < 2; ++bj) { f32x4 v0 = acc[ai][bj][m][0], v1 = acc[ai][bj][m][1];
                    if (MODE == 0) { v0 = v0 + bv[bj][0]; v1 = v1 + bv[bj][1];
#pragma unroll
                        for (int j = 0; j < 4; ++j) { v0[j] = fast_sigmoid(v0[j]); v1[j] = fast_sigmoid(v1[j]); } }
                    else { v0 = v0 * bv[bj][0]; v1 = v1 * bv[bj][1]; }
                    u32x4 w; w.x = cvt_pk_bf16(v0[0], v0[1]); w.y = cvt_pk_bf16(v0[2], v0[3]); w.z = cvt_pk_bf16(v1[0], v1[1]); w.w = cvt_pk_bf16(v1[2], v1[3]);
                    *(u32x4*)(rowp + bj * HALF) = w; } }
    }
};
struct EpiMerge {
    static constexpr bool PERM = true;
    const bf16_t* gates; bf16_t* merged;
    __device__ __forceinline__ void operator()(const Acc& acc, const Unit& u, int wr, int wc, int fr, int fq) const {
        const int row0 = u.pm * BM + wr * 64 + fr, col0 = u.pn * BM + wc * 32 + 8 * fq;
#pragma unroll
        for (int ai = 0; ai < 2; ++ai)
#pragma unroll
            for (int m = 0; m < 4; ++m) { const size_t row = (size_t)(row0 + ai * HALF + m * 16);
#pragma unroll
                for (int bj = 0; bj < 2; ++bj) { const int col = col0 + bj * HALF;
                    const u32x4 gv = *(const u32x4*)(gates + row * (3 * DM) + u.z * DM + col);
                    u32x4 pv = (u32x4){0u, 0u, 0u, 0u}; if (u.z > 0) pv = *(const u32x4*)(merged + row * DM + col);
                    const f32x4 v0 = acc[ai][bj][m][0], v1 = acc[ai][bj][m][1]; u32x4 w;
                    w.x = cvt_pk_bf16(bf_lo(pv.x) + bf_lo(gv.x) * v0[0], bf_hi(pv.x) + bf_hi(gv.x) * v0[1]);
                    w.y = cvt_pk_bf16(bf_lo(pv.y) + bf_lo(gv.y) * v0[2], bf_hi(pv.y) + bf_hi(gv.y) * v0[3]);
                    w.z = cvt_pk_bf16(bf_lo(pv.z) + bf_lo(gv.z) * v1[0], bf_hi(pv.z) + bf_hi(gv.z) * v1[1]);
                    w.w = cvt_pk_bf16(bf_lo(pv.w) + bf_lo(gv.w) * v1[2], bf_hi(pv.w) + bf_hi(gv.w) * v1[3]);
                    *(u32x4*)(merged + row * DM + col) = w; } }
    }
};
struct EpiGateMerge {
    static constexpr bool PERM = true;
    bf16_t* scr01; bf16_t* scr2; bf16_t* merged; const float* bgate;
    __device__ __forceinline__ void operator()(const Acc& acc, const Unit& u, int wr, int wc, int fr, int fq) const {
        asm volatile("" : "+v"(fr), "+v"(fq));
        const int lrow0 = wr * 64 + fr, lcol0 = wc * 32 + 8 * fq;
        bf16_t* scratch = ((u.z >> 1) < 2) ? scr01 + (u.z >> 1) * 65536 : scr2;
        if (!(u.z & 1)) {
            const float* bp = bgate + (u.z >> 1) * DM + u.pn * BM + lcol0;
            f32x4 bv[2][2];
#pragma unroll
            for (int bj = 0; bj < 2; ++bj)
#pragma unroll
                for (int n = 0; n < 2; ++n) bv[bj][n] = *(const f32x4*)(bp + bj * HALF + 4 * n);
#pragma unroll
            for (int ai = 0; ai < 2; ++ai)
#pragma unroll
                for (int m = 0; m < 4; ++m) { bf16_t* rowp = scratch + (lrow0 + ai * HALF + m * 16) * 256 + lcol0;
#pragma unroll
                    for (int bj = 0; bj < 2; ++bj) { f32x4 v0 = acc[ai][bj][m][0] + bv[bj][0], v1 = acc[ai][bj][m][1] + bv[bj][1];
#pragma unroll
                        for (int j = 0; j < 4; ++j) { v0[j] = fast_sigmoid(v0[j]); v1[j] = fast_sigmoid(v1[j]); }
                        u32x4 w; w.x = cvt_pk_bf16(v0[0], v0[1]); w.y = cvt_pk_bf16(v0[2], v0[3]); w.z = cvt_pk_bf16(v1[0], v1[1]); w.w = cvt_pk_bf16(v1[2], v1[3]);
                        *(u32x4*)(rowp + bj * HALF) = w; } }
        } else {
#pragma unroll
            for (int ai = 0; ai < 2; ++ai)
#pragma unroll
                for (int m = 0; m < 4; ++m) { const int lrow = lrow0 + ai * HALF + m * 16; bf16_t* mrow = merged + (size_t)(u.pm * BM + lrow) * DM + u.pn * BM + lcol0;
#pragma unroll
                    for (int bj = 0; bj < 2; ++bj) {
                        const u32x4 gv = *(const u32x4*)(scratch + lrow * 256 + lcol0 + bj * HALF);
                        u32x4 pv = (u32x4){0u, 0u, 0u, 0u}; if (u.z > 1) pv = *(const u32x4*)(mrow + bj * HALF);
                        const f32x4 v0 = acc[ai][bj][m][0], v1 = acc[ai][bj][m][1]; u32x4 w;
                        w.x = cvt_pk_bf16(bf_lo(pv.x) + bf_lo(gv.x) * v0[0], bf_hi(pv.x) + bf_hi(gv.x) * v0[1]);
                        w.y = cvt_pk_bf16(bf_lo(pv.y) + bf_lo(gv.y) * v0[2], bf_hi(pv.y) + bf_hi(gv.y) * v0[3]);
                        w.z = cvt_pk_bf16(bf_lo(pv.z) + bf_lo(gv.z) * v1[0], bf_hi(pv.z) + bf_hi(gv.z) * v1[1]);
                        w.w = cvt_pk_bf16(bf_lo(pv.w) + bf_lo(gv.w) * v1[2], bf_hi(pv.w) + bf_hi(gv.w) * v1[3]);
                        *(u32x4*)(mrow + bj * HALF) = w; } }
        }
    }
};
struct EpiResid {
    static constexpr bool PERM = false;
    const float* base; float* out;
    __device__ __forceinline__ void operator()(const Acc& acc, const Unit& u, int wr, int wc, int fr, int fq) const {
        const int row0 = u.pm * BM + wr * 64 + fr, col0 = u.pn * BM + wc * 32 + 4 * fq;
#pragma unroll
        for (int ai = 0; ai < 2; ++ai)
#pragma unroll
            for (int m = 0; m < 4; ++m) { const size_t off = (size_t)(row0 + ai * HALF + m * 16) * DM + col0;
#pragma unroll
                for (int bj = 0; bj < 2; ++bj)
#pragma unroll
                    for (int n = 0; n < 2; ++n) { const f32x4 bs = *(const f32x4*)(base + off + bj * HALF + n * 16);
                        *(f32x4*)(out + off + bj * HALF + n * 16) = bs + acc[ai][bj][m][n]; } }
    }
};
struct EpiSwiglu {
    static constexpr bool PERM = true;
    bf16_t* act;
    __device__ __forceinline__ void operator()(const Acc& acc, const Unit& u, int wr, int wc, int fr, int fq) const {
        const int row0 = u.pm * BM + wr * 64 + fr, col0 = u.pn * 128 + wc * 32 + 8 * fq;
#pragma unroll
        for (int ai = 0; ai < 2; ++ai)
#pragma unroll
            for (int m = 0; m < 4; ++m) { bf16_t* rowp = act + (size_t)(row0 + ai * HALF + m * 16) * DFF + col0;
                f32x4 r0, r1; const f32x4 g0 = acc[ai][0][m][0], g1 = acc[ai][0][m][1], u0 = acc[ai][1][m][0], u1 = acc[ai][1][m][1];
#pragma unroll
                for (int j = 0; j < 4; ++j) { r0[j] = g0[j] * fast_sigmoid(g0[j]) * u0[j]; r1[j] = g1[j] * fast_sigmoid(g1[j]) * u1[j]; }
                u32x4 w; w.x = cvt_pk_bf16(r0[0], r0[1]); w.y = cvt_pk_bf16(r0[2], r0[3]); w.z = cvt_pk_bf16(r1[0], r1[1]); w.w = cvt_pk_bf16(r1[2], r1[3]);
                *(u32x4*)rowp = w; }
    }
};
}

__device__ __forceinline__ void transpose_item(const float* W, int K, int N, bf16_t* WT, int row_off, int mode, LAS float* scr, int item, int lane) {
    const int nblk = N / 32, kb = item / nblk, nb = item % nblk, k0 = 64 * kb, n0 = 32 * nb;
    const float* wp = W + (size_t)(k0 + (lane >> 5)) * N + n0 + (lane & 31);
    float wv[32];
#pragma unroll
    for (int i = 0; i < 32; ++i) wv[i] = wp[(size_t)(2 * i) * N];
#pragma unroll
    for (int i = 0; i < 32; ++i) scr[(2 * i + (lane >> 5)) * 33 + (lane & 31)] = wv[i];
    asm volatile("s_waitcnt lgkmcnt(0)" ::: "memory");
    const int c = lane & 7;
#pragma unroll
    for (int j = 0; j < 4; ++j) { const int n = (lane >> 3) + 8 * j; const LAS float* s = scr + (8 * c) * 33 + n;
        u32x4 o; o.x = cvt_pk_bf16(s[0 * 33], s[1 * 33]); o.y = cvt_pk_bf16(s[2 * 33], s[3 * 33]); o.z = cvt_pk_bf16(s[4 * 33], s[5 * 33]); o.w = cvt_pk_bf16(s[6 * 33], s[7 * 33]);
        const int ng = n0 + n; const int drow = (mode == 0) ? (row_off + ng) : (256 * (ng >> 7) + (ng & 127) + 128 * (mode - 1));
        *(u32x4*)(WT + (size_t)drow * K + k0 + 8 * c) = o; }
    asm volatile("s_waitcnt lgkmcnt(0)" ::: "memory");
}

struct Params { const float* in[21]; float* out; unsigned char* ws; int lo, hi, dbg, pad; };

__device__ __forceinline__ void convert_weights(const Params& P, int l, LAS unsigned char* lds, int gw, int NGW, int wave, int lane) {
    LAS float* scr = (LAS float*)(lds + wave * 16384);
    unsigned char* ws = P.ws;
    constexpr int I_IN = 16 * 256, I_POOL = 4 * 8, I_BR = 16 * 32, I_OUT = 16 * 32, I_G = 16 * 88, I_D = 44 * 32;
    constexpr int NITEMS = I_IN + 4 * I_POOL + 3 * I_BR + I_OUT + 2 * I_G + I_D;
    for (int it = gw; it < NITEMS; it += NGW) {
        int r = it;
        if (r < I_IN) { transpose_item(P.in[2] + (size_t)l * DM * 8192, DM, 8192, (bf16_t*)(ws + W_IN), 0, 0, scr, r, lane); continue; } r -= I_IN;
        if (r < 4 * I_POOL) {
            const int row0 = r * 8;
#pragma unroll
            for (int rr = 0; rr < 8; ++rr) { const int row = row0 + rr; const int g = row >> 8;
                const f32x4 wv4 = *(const f32x4*)(P.in[4] + (size_t)l * 4 * 65536 + (size_t)row * 256 + lane * 4);
                const f32x4 sc4 = *(const f32x4*)(P.in[5] + (size_t)l * DM + g * 256 + lane * 4);
                u32x2 o; o.x = cvt_pk_bf16(wv4[0] * sc4[0], wv4[1] * sc4[1]); o.y = cvt_pk_bf16(wv4[2] * sc4[2], wv4[3] * sc4[3]);
                *(u32x2*)((bf16_t*)(ws + W_POOL) + (size_t)row * 256 + lane * 4) = o; }
            continue; } r -= 4 * I_POOL;
        if (r < 3 * I_BR) { const int b = r / I_BR; transpose_item(P.in[15] + (size_t)(l * 3 + b) * DM * DM, DM, DM, (bf16_t*)(ws + W_BR) + (size_t)b * DM * DM, 0, 0, scr, r % I_BR, lane); continue; } r -= 3 * I_BR;
        if (r < I_OUT) { transpose_item(P.in[16] + (size_t)l * DM * DM, DM, DM, (bf16_t*)(ws + W_OUT), 0, 0, scr, r, lane); continue; } r -= I_OUT;
        if (r < I_G) { transpose_item(P.in[18] + (size_t)l * DM * DFF, DM, DFF, (bf16_t*)(ws + W_GU), 0, 1, scr, r, lane); continue; } r -= I_G;
        if (r < I_G) { transpose_item(P.in[19] + (size_t)l * DM * DFF, DM, DFF, (bf16_t*)(ws + W_GU), 0, 2, scr, r, lane); continue; } r -= I_G;
        transpose_item(P.in[20] + (size_t)l * DFF * DM, DFF, DM, (bf16_t*)(ws + W_DOWN), 0, 0, scr, r, lane);
    }
}

__device__ __forceinline__ void rms_rows(const float* x, const float* g, bf16_t* out, int gw, int NGW, int lane) {
    f32x4 gg[4];
#pragma unroll
    for (int j = 0; j < 4; ++j) gg[j] = ((const f32x4*)g)[64 * j + lane];
    for (int m = gw; m < MTOK; m += 2 * NGW) {
        const int m2 = m + NGW; const bool has2 = m2 < MTOK;
        const f32x4* xr = (const f32x4*)(x + (size_t)m * DM) + lane; const f32x4* xr2 = (const f32x4*)(x + (size_t)(has2 ? m2 : m) * DM) + lane;
        f32x4 v[4], v2[4]; float s = 0.f, s2 = 0.f;
#pragma unroll
        for (int j = 0; j < 4; ++j) { v[j] = xr[64 * j]; v2[j] = xr2[64 * j]; }
#pragma unroll
        for (int j = 0; j < 4; ++j) { s += (v[j][0] * v[j][0] + v[j][1] * v[j][1]) + (v[j][2] * v[j][2] + v[j][3] * v[j][3]); s2 += (v2[j][0] * v2[j][0] + v2[j][1] * v2[j][1]) + (v2[j][2] * v2[j][2] + v2[j][3] * v2[j][3]); }
        const float rstd = rsqrtf(wave_sum(s) * (1.f / DM) + EPS), rstd2 = rsqrtf(wave_sum(s2) * (1.f / DM) + EPS);
        u32x2* o = (u32x2*)(out + (size_t)m * DM) + lane; u32x2* o2 = (u32x2*)(out + (size_t)m2 * DM) + lane;
#pragma unroll
        for (int j = 0; j < 4; ++j) { u32x2 w;
            w.x = cvt_pk_bf16(v[j][0] * rstd * gg[j][0], v[j][1] * rstd * gg[j][1]); w.y = cvt_pk_bf16(v[j][2] * rstd * gg[j][2], v[j][3] * rstd * gg[j][3]); o[64 * j] = w;
            if (has2) { w.x = cvt_pk_bf16(v2[j][0] * rstd2 * gg[j][0], v2[j][1] * rstd2 * gg[j][1]); w.y = cvt_pk_bf16(v2[j][2] * rstd2 * gg[j][2], v2[j][3] * rstd2 * gg[j][3]); o2[64 * j] = w; } }
    }
}

__device__ __forceinline__ void qk_norm_rows(bf16_t* q, bf16_t* k, const float* qg, const float* kg, int gw, int NGW, int lane) {
    const int d0 = (lane & 7) * 16;
    for (int it = gw; it < 2 * MTOK; it += NGW) {
        const int which = it >= MTOK; const int m = it - which * MTOK;
        bf16_t* p = (which ? k : q) + (size_t)m * DM + lane * 16; const float* gg = (which ? kg : qg) + d0;
        const u32x4 a = *(const u32x4*)p, b = *(const u32x4*)(p + 8);
        float v[16];
        v[0] = bf_lo(a.x); v[1] = bf_hi(a.x); v[2] = bf_lo(a.y); v[3] = bf_hi(a.y); v[4] = bf_lo(a.z); v[5] = bf_hi(a.z); v[6] = bf_lo(a.w); v[7] = bf_hi(a.w);
        v[8] = bf_lo(b.x); v[9] = bf_hi(b.x); v[10] = bf_lo(b.y); v[11] = bf_hi(b.y); v[12] = bf_lo(b.z); v[13] = bf_hi(b.z); v[14] = bf_lo(b.w); v[15] = bf_hi(b.w);
        float ss = 0.f;
#pragma unroll
        for (int e = 0; e < 16; ++e) ss += v[e] * v[e];
        ss += __shfl_xor(ss, 1); ss += __shfl_xor(ss, 2); ss += __shfl_xor(ss, 4);
        const float rstd = rsqrtf(ss * (1.f / HD) + EPS);
        unsigned w[8];
#pragma unroll
        for (int e = 0; e < 8; ++e) w[e] = cvt_pk_bf16(v[2 * e] * rstd * gg[2 * e], v[2 * e + 1] * rstd * gg[2 * e + 1]);
        *(u32x4*)p = (u32x4){w[0], w[1], w[2], w[3]}; *(u32x4*)(p + 8) = (u32x4){w[4], w[5], w[6], w[7]};
    }
}

__device__ __forceinline__ void unpack8(const u32x4 a, float (&v)[8]) { v[0] = bf_lo(a.x); v[1] = bf_hi(a.x); v[2] = bf_lo(a.y); v[3] = bf_hi(a.y); v[4] = bf_lo(a.z); v[5] = bf_hi(a.z); v[6] = bf_lo(a.w); v[7] = bf_hi(a.w); }
__device__ __forceinline__ void pool_elem(const bf16_t* u, bf16_t* p, int gtid, int NT) {
    for (int id = gtid; id < BATCH * 128 * 128; id += NT) {
        const int oct = id & 127, strip = (id >> 7) & 127, b = id >> 14;
        const int c0 = oct * 8, w = 2 << (c0 >> 8), t0 = strip * 16;
        const bf16_t* ub = u + (size_t)b * SEQ * DM + c0; bf16_t* pb = p + (size_t)b * SEQ * DM + c0;
        float S[8];
#pragma unroll
        for (int e = 0; e < 8; ++e) S[e] = 0.f;
        for (int k = 1; k <= w; ++k) { const int t = t0 - k; if (t >= 0) { float v[8]; unpack8(*(const u32x4*)(ub + (size_t)t * DM), v);
#pragma unroll
                for (int e = 0; e < 8; ++e) S[e] += v[e]; } }
        for (int i = 0; i < 16; ++i) { const int t = t0 + i; float v[8]; unpack8(*(const u32x4*)(ub + (size_t)t * DM), v);
            if (t - w >= 0) { float o[8]; unpack8(*(const u32x4*)(ub + (size_t)(t - w) * DM), o);
#pragma unroll
                for (int e = 0; e < 8; ++e) S[e] -= o[e]; }
            const float inv = 1.f / (float)((t + 1) < w ? (t + 1) : w); float r[8];
#pragma unroll
            for (int e = 0; e < 8; ++e) { S[e] += v[e]; r[e] = S[e] * inv - v[e]; }
            *(u32x4*)(pb + (size_t)t * DM) = (u32x4){cvt_pk_bf16(r[0], r[1]), cvt_pk_bf16(r[2], r[3]), cvt_pk_bf16(r[4], r[5]), cvt_pk_bf16(r[6], r[7])}; }
    }
}

__device__ __forceinline__ void pool_tile(const bf16_t* u, bf16_t* p, int pm, int g, int tid) {
    const int oct = tid & 31, strip = tid >> 5;
    const int c0 = g * 256 + oct * 8, w = 2 << g, row0 = pm * 256 + strip * 16, b = row0 >> 11, t0 = row0 & 2047;
    const bf16_t* ub = u + (size_t)b * SEQ * DM + c0; bf16_t* pb = p + (size_t)b * SEQ * DM + c0;
    float S[8];
#pragma unroll
    for (int e = 0; e < 8; ++e) S[e] = 0.f;
#pragma unroll 8
    for (int k = 1; k <= 16; ++k) { const int t = t0 - k; if (k <= w && t >= 0) { float v[8]; unpack8(*(const u32x4*)(ub + (size_t)t * DM), v);
#pragma unroll
            for (int e = 0; e < 8; ++e) S[e] += v[e]; } }
#pragma unroll 4
    for (int i = 0; i < 16; ++i) { const int t = t0 + i; float v[8], o[8]; unpack8(*(const u32x4*)(ub + (size_t)t * DM), v);
        const int tl = (t - w >= 0) ? (t - w) : t; unpack8(*(const u32x4*)(ub + (size_t)tl * DM), o);
        const float keep = (t - w >= 0) ? 1.f : 0.f;
        const float inv = 1.f / (float)((t + 1) < w ? (t + 1) : w); float r[8];
#pragma unroll
        for (int e = 0; e < 8; ++e) { S[e] = S[e] - keep * o[e] + v[e]; r[e] = S[e] * inv - v[e]; }
        *(u32x4*)(pb + (size_t)t * DM) = (u32x4){cvt_pk_bf16(r[0], r[1]), cvt_pk_bf16(r[2], r[3]), cvt_pk_bf16(r[4], r[5]), cvt_pk_bf16(r[6], r[7])}; }
}

__device__ __forceinline__ void lru_combine(float& A, float& H, float Ax, float Hx) { H = A * Hx + H; A = A * Ax; }
__device__ __forceinline__ void lru_phase(const Params& P, int l, LAS unsigned char* lds, bf16_t* ulru, int G, int c) {
    int tid = threadIdx.x; asm volatile("" : "+v"(tid));
    const int lane = tid & 63, wave = __builtin_amdgcn_readfirstlane(tid >> 6), l15 = lane & 15, q = lane >> 4;
    LAS float* XC = (LAS float*)lds;
    LAS bf16_t* XCB = (LAS bf16_t*)(lds + 65536);
    LAS float* GT = (LAS float*)(lds + 65536 + 36864);
    LAS bf16x8* WF = (LAS bf16x8*)(lds + 65536 + 36864 + 8192);
    const float* conv_w = P.in[6] + (size_t)l * 4 * DM; const float* conv_b = P.in[7] + (size_t)l * DM;
    const float* w_rg = P.in[8] + (size_t)l * 16 * 4096; const float* b_rg = P.in[9] + (size_t)l * DM;
    const float* w_ig = P.in[10] + (size_t)l * 16 * 4096; const float* b_ig = P.in[11] + (size_t)l * DM;
    const float* lam = P.in[12] + (size_t)l * DM;
    for (int it = c; it < BATCH * 16; it += G) {
        const int b = it >> 4, hb = it & 15, ch0 = hb * 64;
        const int chl = ch0 + lane;
        const float cw0 = conv_w[chl], cw1 = conv_w[DM + chl], cw2 = conv_w[2 * DM + chl], cw3 = conv_w[3 * DM + chl], cb = conv_b[chl];
        float brg[4], big[4], sp8[4], carry[4];
#pragma unroll
        for (int nt = 0; nt < 4; ++nt) { const int ch = ch0 + 16 * nt + l15; brg[nt] = b_rg[ch]; big[nt] = b_ig[ch]; carry[nt] = 0.f;
            const float x = -lam[ch]; sp8[nt] = -8.0f * (fmaxf(x, 0.f) + log1pf(__expf(-fabsf(x)))); }
        bf16_t* ubase = ulru + (size_t)b * SEQ * DM + ch0;
        __syncthreads();
#pragma unroll
        for (int k = 0; k < 4; ++k) { const int idx = tid * 4 + k * 2048;
            const f32x4 wv4 = *(const f32x4*)((idx < 4096 ? w_rg + (size_t)hb * 4096 + idx : w_ig + (size_t)hb * 4096 + (idx - 4096)));
            *(LAS f32x4*)(XC + idx) = wv4; }
        __syncthreads();
#pragma unroll
        for (int nt = 0; nt < 8; ++nt)
#pragma unroll
            for (int ks = 0; ks < 2; ++ks) { const LAS float* wsrc = XC + (nt < 4 ? 0 : 4096) + 16 * (nt & 3) + l15;
                const int k0 = ks * 32 + q * 8; unsigned pk[4];
#pragma unroll
                for (int e = 0; e < 4; ++e) pk[e] = cvt_pk_bf16(wsrc[(k0 + 2 * e) * 64], wsrc[(k0 + 2 * e + 1) * 64]);
                u32x4 t4 = (u32x4){pk[0], pk[1], pk[2], pk[3]};
                WF[(nt * 2 + ks) * 64 + lane] = __builtin_bit_cast(bf16x8, t4); }
        __syncthreads();
        unsigned short pre[35];
#pragma unroll
        for (int i = 0; i < 35; ++i) { const int t = 32 * wave - 3 + i; pre[i] = (t >= 0) ? ubase[(size_t)t * DM + lane] : (unsigned short)0; }
        for (int ck = 0; ck < SEQ / 256; ++ck) {
            const int t0 = ck * 256, par = ck & 1;
            { float uf[35];
#pragma unroll
                for (int i = 0; i < 35; ++i) uf[i] = __uint_as_float((unsigned)pre[i] << 16);
#pragma unroll
                for (int i = 0; i < 32; ++i) { const int t = 32 * wave + i; const float xc = cb + cw0 * uf[i] + cw1 * uf[i + 1] + cw2 * uf[i + 2] + cw3 * uf[i + 3];
                    XC[t * 64 + lane] = xc; XCB[t * 72 + lane] = (bf16_t)(cvt_pk_bf16(xc, 0.f) & 0xffffu); } }
            if (ck + 1 < SEQ / 256) {
#pragma unroll
                for (int i = 0; i < 35; ++i) pre[i] = ubase[(size_t)(t0 + 256 + 32 * wave - 3 + i) * DM + lane]; }
            asm volatile("s_waitcnt lgkmcnt(0)" ::: "memory");
            float Ac[2][4][4], Hl[2][4][4], EA[2][4], EH[2][4], TA0[4], TH0[4];
#pragma unroll
            for (int mt = 0; mt < 2; ++mt) {
                f32x4 ga[8];
                { float zf = 0.f; asm volatile("" : "+v"(zf));
#pragma unroll
                  for (int nt = 0; nt < 8; ++nt) ga[nt] = (f32x4){zf, zf, zf, zf}; }
#pragma unroll
                for (int ks = 0; ks < 2; ++ks) { const bf16x8 af = *(const LAS bf16x8*)(XCB + (wave * 32 + mt * 16 + l15) * 72 + ks * 32 + q * 8);
#pragma unroll
                    for (int nt = 0; nt < 8; ++nt) ga[nt] = __builtin_amdgcn_mfma_f32_16x16x32_bf16(af, WF[(nt * 2 + ks) * 64 + lane], ga[nt], 0, 0, 0); }
#pragma unroll
                for (int nt = 0; nt < 4; ++nt) {
                    float A = 1.f, H = 0.f;
#pragma unroll
                    for (int j = 0; j < 4; ++j) { const int t = wave * 32 + mt * 16 + 4 * q + j, ch = 16 * nt + l15;
                        const float r = fast_sigmoid(ga[nt][j] + brg[nt]), ig = fast_sigmoid(ga[nt + 4][j] + big[nt]);
                        const float log_a = r * sp8[nt]; const float a = __expf(log_a); const float x2 = 2.0f * log_a;
                        const float om = (x2 > -0.02f) ? (-x2 * (1.0f + x2 * (0.5f + x2 * (1.0f / 6.0f + x2 * (1.0f / 24.0f))))) : (1.0f - a * a);
                        const float bb = __builtin_amdgcn_sqrtf(om) * (ig * XC[t * 64 + ch]);
                        H = a * H + bb; A = a * A; Ac[mt][nt][j] = A; Hl[mt][nt][j] = H; }
                    { const float Ax = __shfl_up(A, 16), Hx = __shfl_up(H, 16); if (q >= 1) lru_combine(A, H, Ax, Hx); }
                    { const float Ax = __shfl_up(A, 32), Hx = __shfl_up(H, 32); if (q >= 2) lru_combine(A, H, Ax, Hx); }
                    { const float Ax = __shfl_up(A, 16), Hx = __shfl_up(H, 16); EA[mt][nt] = (q >= 1) ? Ax : 1.f; EH[mt][nt] = (q >= 1) ? Hx : 0.f; }
                    const float TA = __shfl(A, 48 + l15), TH = __shfl(H, 48 + l15);
                    if (mt == 0) { TA0[nt] = TA; TH0[nt] = TH; }
                    else { float WA = TA, WH = TH; lru_combine(WA, WH, TA0[nt], TH0[nt]);
                        if (q == 0) { GT[((par * 8 + wave) * 2 + 0) * 64 + 16 * nt + l15] = WA; GT[((par * 8 + wave) * 2 + 1) * 64 + 16 * nt + l15] = WH; } }
                }
            }
            asm volatile("s_waitcnt vmcnt(0) lgkmcnt(0)" ::: "memory");
            __syncthreads();
#pragma unroll
            for (int nt = 0; nt < 4; ++nt) { const int ch = 16 * nt + l15; float hin = carry[nt], hall = carry[nt];
#pragma unroll
                for (int g2 = 0; g2 < 8; ++g2) { const float ga2 = GT[((par * 8 + g2) * 2 + 0) * 64 + ch], gh2 = GT[((par * 8 + g2) * 2 + 1) * 64 + ch]; hall = ga2 * hall + gh2; if (g2 < wave) hin = hall; }
                carry[nt] = hall;
#pragma unroll
                for (int mt = 0; mt < 2; ++mt) { const float sin_mt = (mt == 0) ? hin : (TA0[nt] * hin + TH0[nt]); const float s = EA[mt][nt] * sin_mt + EH[mt][nt];
#pragma unroll
                    for (int j = 0; j < 4; ++j) { const float h = Ac[mt][nt][j] * s + Hl[mt][nt][j];
                        ubase[(size_t)(t0 + wave * 32 + mt * 16 + 4 * q + j) * DM + ch] = (bf16_t)(cvt_pk_bf16(h, 0.f) & 0xffffu); } } }
        }
    }
}

__device__ __forceinline__ void attn_phase(LAS unsigned char* lds, bf16_t* qn, const bf16_t* kn, const bf16_t* vT, int G, int c) {
    int tid = threadIdx.x; asm volatile("" : "+v"(tid));
    const int lane = tid & 63, w = __builtin_amdgcn_readfirstlane(tid >> 6), l31 = lane & 31, hi = lane >> 5;
    constexpr int KSTR = 272, VSTR = 72, KBYTES = 32 * KSTR, VBYTES = 128 * VSTR, WBYTES = KBYTES + VBYTES;
    LAS unsigned char* Kt = lds + w * WBYTES; LAS unsigned char* Vt = Kt + KBYTES;
    const float scale2 = 0.08838834764831845f * 1.4426950408889634f;
    constexpr int NITEM = BATCH * NH * (SEQ / 32);
    const int kst = (lane >> 4) * KSTR + (lane & 15) * 16, vst = (lane >> 2) * VSTR + (lane & 3) * 16;
    __syncthreads();
    for (int L = c * 8 + w; L < NITEM; L += G * 8) {
        const int qb = (SEQ / 32 - 1) - (L >> 7), bh = L & 127, b = bh >> 3, h = bh & 7;
        const size_t tokbase = (size_t)b * SEQ;
        const int qmin = qb * 32, qrow = qmin + l31;
        bf16x8 qf[8];
        { const bf16_t* qp = qn + (tokbase + qrow) * DM + h * HD + hi * 8;
#pragma unroll
            for (int ks = 0; ks < 8; ++ks) qf[ks] = *(const bf16x8*)(qp + ks * 16); }
        f32x16 O[4];
#pragma unroll
        for (int db = 0; db < 4; ++db)
#pragma unroll
            for (int e = 0; e < 16; ++e) O[db][e] = 0.f;
        float R = 0.f;
        const bf16_t* kbase = kn + tokbase * DM + h * HD + (size_t)(lane >> 4) * DM + (lane & 15) * 8;
        const bf16_t* vbase = vT + ((size_t)((b * NH + h) * HD) + (lane >> 2)) * SEQ + (lane & 3) * 8;
        u32x4 st[8];
#pragma unroll
        for (int i = 0; i < 8; ++i) st[i] = *(const u32x4*)(kbase + (size_t)(qb * 32 + 4 * i) * DM);
        for (int kt = qb; kt >= 0; --kt) {
            const int k0 = kt * 32;
            asm volatile("" ::: "memory");
#pragma unroll
            for (int i = 0; i < 8; ++i) *(LAS u32x4*)(Kt + kst + 4 * i * KSTR) = st[i];
#pragma unroll
            for (int i = 0; i < 8; ++i) st[i] = *(const u32x4*)(vbase + (size_t)(16 * i) * SEQ + k0);
            asm volatile("s_waitcnt lgkmcnt(0)" ::: "memory");
            f32x16 s, s1;
            { float zf = 0.f; asm volatile("" : "+v"(zf));
#pragma unroll
              for (int e = 0; e < 16; ++e) { s[e] = zf; s1[e] = zf; } }
            { bf16x8 kf[8];
#pragma unroll
              for (int ks = 0; ks < 8; ++ks) kf[ks] = *(const LAS bf16x8*)(Kt + l31 * KSTR + (ks * 16 + hi * 8) * 2);
              asm volatile("s_waitcnt lgkmcnt(0)" ::: "memory");
#pragma unroll
              for (int ks = 0; ks < 8; ks += 2) { s = __builtin_amdgcn_mfma_f32_32x32x16_bf16(kf[ks], qf[ks], s, 0, 0, 0);
                  s1 = __builtin_amdgcn_mfma_f32_32x32x16_bf16(kf[ks + 1], qf[ks + 1], s1, 0, 0, 0); } }
#pragma unroll
            for (int e = 0; e < 16; ++e) s[e] += s1[e];
            const bool diag = (kt == qb);
            float ls[16], lk[16];
#pragma unroll
            for (int e = 0; e < 16; ++e) { const float z = s[e] * scale2;
                const float sp = __builtin_amdgcn_logf(1.0f + __builtin_amdgcn_exp2f(-fabsf(z)));
                float lse = fminf(z, 0.f) - sp, lke = lse - z;
                if (diag) { const int key = k0 + 8 * (e >> 2) + 4 * hi + (e & 3); if (key >= qrow) { lke = 0.f; lse = -INFINITY; } }
                ls[e] = lse; lk[e] = lke; }
            float gs[4], gp[4];
#pragma unroll
            for (int bb = 0; bb < 4; ++bb) { gs[bb] = (lk[4 * bb] + lk[4 * bb + 1]) + (lk[4 * bb + 2] + lk[4 * bb + 3]); gp[bb] = __shfl_xor(gs[bb], 32); }
            float wv[16]; float E = R;
#pragma unroll
            for (int bb = 3; bb >= 0; --bb) { float base = hi ? E : E + gp[bb];
                wv[4 * bb + 3] = __builtin_amdgcn_exp2f(ls[4 * bb + 3] + base); base += lk[4 * bb + 3];
                wv[4 * bb + 2] = __builtin_amdgcn_exp2f(ls[4 * bb + 2] + base); base += lk[4 * bb + 2];
                wv[4 * bb + 1] = __builtin_amdgcn_exp2f(ls[4 * bb + 1] + base); base += lk[4 * bb + 1];
                wv[4 * bb + 0] = __builtin_amdgcn_exp2f(ls[4 * bb + 0] + base);
                E += gs[bb] + gp[bb]; }
            R = E;
            asm volatile("" ::: "memory");
#pragma unroll
            for (int i = 0; i < 8; ++i) { LAS unsigned char* d_ = Vt + vst + 16 * i * VSTR;
                *(LAS u32x2*)d_ = (u32x2){st[i].x, st[i].y}; *(LAS u32x2*)(d_ + 8) = (u32x2){st[i].z, st[i].w}; }
            if (kt > 0) {
#pragma unroll
                for (int i = 0; i < 8; ++i) st[i] = *(const u32x4*)(kbase + (size_t)(k0 - 32 + 4 * i) * DM); }
            asm volatile("s_waitcnt lgkmcnt(0)" ::: "memory");
            { u32x4 vb4[2][4];
#pragma unroll
              for (int p = 0; p < 2; ++p)
#pragma unroll
                for (int db = 0; db < 4; ++db) { const LAS unsigned char* vp = Vt + (32 * db + l31) * VSTR + (16 * p + 4 * hi) * 2;
                    const u32x2 v0 = *(const LAS u32x2*)vp, v1 = *(const LAS u32x2*)(vp + 16); vb4[p][db] = (u32x4){v0.x, v0.y, v1.x, v1.y}; }
              asm volatile("s_waitcnt lgkmcnt(0)" ::: "memory");
#pragma unroll
              for (int p = 0; p < 2; ++p) {
                u32x4 pa4 = (u32x4){cvt_pk_bf16(wv[8 * p], wv[8 * p + 1]), cvt_pk_bf16(wv[8 * p + 2], wv[8 * p + 3]), cvt_pk_bf16(wv[8 * p + 4], wv[8 * p + 5]), cvt_pk_bf16(wv[8 * p + 6], wv[8 * p + 7])};
                const bf16x8 pa = __builtin_bit_cast(bf16x8, pa4);
#pragma unroll
                for (int db = 0; db < 4; ++db) O[db] = __builtin_amdgcn_mfma_f32_32x32x16_bf16(pa, __builtin_bit_cast(bf16x8, vb4[p][db]), O[db], 0, 0, 0); } }
            if (__all(R < -150.8f)) break;
        }
#pragma unroll
        for (int db = 0; db < 4; ++db)
#pragma unroll
            for (int e = 0; e < 16; ++e) { const int q = qmin + 8 * (e >> 2) + 4 * hi + (e & 3);
                qn[(tokbase + q) * DM + h * HD + 32 * db + l31] = (bf16_t)(cvt_pk_bf16(O[db][e], 0.f) & 0xffffu); }
    }
}

#define XB_TMO      128
#define XB_XCNT(j)  (256  + 64 * (j))
#define XB_XSUB(j)  (1280 + 64 * (j))
#define XB_XGEN(j)  (2304 + 64 * (j))
#define XB_TOP      3328
#define XB_TOPGEN   3392
#define XCD_BAR_WORDS 3456
#define XB_SPIN_CAP (1u << 18)
__device__ __forceinline__ unsigned xb_ld(unsigned* p)              { return __hip_atomic_load(p, __ATOMIC_RELAXED, __HIP_MEMORY_SCOPE_AGENT); }
__device__ __forceinline__ unsigned xb_add(unsigned* p, unsigned v) { return __hip_atomic_fetch_add(p, v, __ATOMIC_RELAXED, __HIP_MEMORY_SCOPE_AGENT); }
__device__ __forceinline__ unsigned xb_xcc_id() { return (unsigned)__builtin_amdgcn_s_getreg((3 << 11) | 20) & 0xFu; }
#define XB_SPIN(cond, bar) do { unsigned _sp = 0; while (cond) { __builtin_amdgcn_s_sleep(1); \
    if ((++_sp & 255u) == 0u) { if (xb_ld(&(bar)[XB_TMO])) break; if (_sp > XB_SPIN_CAP) { atomicAdd(&(bar)[XB_TMO], 1u); break; } } } } while (0)
struct XcdBarrier { unsigned* bar; unsigned x; volatile LAS unsigned* st; };
__device__ __forceinline__ XcdBarrier xcd_barrier_post(unsigned* bar, volatile LAS unsigned* st) {
    XcdBarrier b; b.bar = bar; b.x = xb_xcc_id(); b.st = st;
    if (threadIdx.x == 0) st[2] = xb_add(&bar[XB_XCNT(b.x)], 1u);
    return b;
}
__device__ __forceinline__ void xcd_barrier_complete(unsigned* bar, unsigned x, unsigned& nloc, unsigned& nx) {
    const unsigned G = gridDim.x * gridDim.y * gridDim.z;
    unsigned sum, cnt, mine, sp = 0u;
    for (;;) {
        sum = 0u; cnt = 0u; mine = 0u;
#pragma unroll
        for (unsigned j = 0; j < 16; ++j) { const unsigned c = xb_ld(&bar[XB_XCNT(j)]); sum += c; cnt += (c > 0u) ? 1u : 0u; mine = (j == x) ? c : mine; }
        if (sum == G) break;
        __builtin_amdgcn_s_sleep(1);
        if ((++sp & 255u) == 0u) { if (xb_ld(&bar[XB_TMO])) break; if (sp > XB_SPIN_CAP) { atomicAdd(&bar[XB_TMO], 1u); break; } }
    }
    nloc = mine > 0u ? mine : 1u; nx = cnt > 0u ? cnt : 1u;
}
__device__ __forceinline__ void xcd_barrier(const XcdBarrier& b) {
    asm volatile("s_waitcnt vmcnt(0)" ::: "memory");
    __syncthreads();
    if (threadIdx.x == 0) {
        unsigned* bar = b.bar; asm volatile("" : "+s"(bar));
        __builtin_amdgcn_s_waitcnt(0);
        unsigned nloc = b.st[0], nx = b.st[1];
        if (nloc == 0u) { xcd_barrier_complete(bar, b.x, nloc, nx); b.st[0] = nloc; b.st[1] = nx; }
        const unsigned old = xb_add(&bar[XB_XSUB(b.x)], 1u);
        const unsigned gen = old / nloc;
        if (old + 1u == (gen + 1u) * nloc) {
            __builtin_amdgcn_fence(__ATOMIC_RELEASE, "agent");
            asm volatile("s_waitcnt vmcnt(0)" ::: "memory");
            const unsigned og = xb_add(&bar[XB_TOP], 1u);
            const unsigned tg = og / nx;
            if (og + 1u == (tg + 1u) * nx) xb_add(&bar[XB_TOPGEN], 1u);
            else XB_SPIN(xb_ld(&bar[XB_TOPGEN]) == tg, bar);
            __builtin_amdgcn_fence(__ATOMIC_ACQUIRE, "agent");
            xb_add(&bar[XB_XGEN(b.x)], 1u);
            asm volatile("s_waitcnt vmcnt(0)" ::: "memory");
        } else {
            XB_SPIN(xb_ld(&bar[XB_XGEN(b.x)]) == gen, bar);
            __builtin_amdgcn_fence(__ATOMIC_ACQUIRE, "agent");
            asm volatile("s_waitcnt vmcnt(0)" ::: "memory");
        }
    }
    __syncthreads();
}

__global__ void __launch_bounds__(512, 2) mega(Params P) {
    extern __shared__ __attribute__((aligned(16))) unsigned char lds_raw[];
    LAS unsigned char* lds = (LAS unsigned char*)lds_raw;
    cg::grid_group grid = cg::this_grid();
    const int G = gridDim.x; int c = blockIdx.x;
    volatile LAS unsigned* bst = (volatile LAS unsigned*)(lds + LDS_BYTES - 64);
    if (threadIdx.x < 2) bst[threadIdx.x] = 0u;
    __syncthreads();
    const XcdBarrier xbar = xcd_barrier_post((unsigned*)(P.ws + WS_CTL), bst);
#define WSL() unsigned char* wsl = P.ws; asm volatile("" : "+s"(wsl))
#define s0 ((bf16_t*)(wsl + SLOT0))
#define s1 (s0 + SLOT_ELEMS)
#define s2 (s0 + 2 * SLOT_ELEMS)
#define s3 (s0 + 3 * SLOT_ELEMS)
#define s4 (s0 + 4 * SLOT_ELEMS)
#define s5 (s0 + 5 * SLOT_ELEMS)
#define s6 (s0 + 6 * SLOT_ELEMS)
#define Win ((const bf16_t*)(wsl + W_IN))
#define Wpool ((const bf16_t*)(wsl + W_POOL))
#define Wbr ((const bf16_t*)(wsl + W_BR))
#define Wout ((const bf16_t*)(wsl + W_OUT))
#define Wgu ((const bf16_t*)(wsl + W_GU))
#define Wdown ((const bf16_t*)(wsl + W_DOWN))
    const int lo = P.lo, hi = P.hi;
#define IN(k) (lo <= (k) && (k) < hi)
#ifndef PROBE_MASK
#define PROBE_MASK 0
#endif
#define PB(k) unsigned long long pt0_ = 0; if ((PROBE_MASK >> (k)) & 1) pt0_ = __builtin_amdgcn_s_memrealtime()
#define PE(k) do { if ((PROBE_MASK >> (k)) & 1) { const unsigned long long pt1_ = __builtin_amdgcn_s_memrealtime(); while (__builtin_amdgcn_s_memrealtime() - pt1_ < pt1_ - pt0_) __builtin_amdgcn_s_sleep(8); } } while (0)
#define SEAM(k) do { if (IN(k) && IN((k) + 1)) { PB(10); \
        if ((k) == 0) { xcd_barrier(xbar);     \
              \
            if (threadIdx.x == 0) { unsigned* bw_ = (unsigned*)(P.ws + WS_CTL); bool ok_ = (G % 8) == 0; \
                for (int j_ = 0; j_ < 16; ++j_) { const unsigned n_ = xb_ld(&bw_[XB_XCNT(j_)]); ok_ = ok_ && (n_ == (j_ < 8 ? (unsigned)(G / 8) : 0u)); } \
                bst[3] = ok_ ? (bst[2] * 8u + xbar.x) : (unsigned)blockIdx.x; } \
            __syncthreads(); c = (int)bst[3]; } \
        else xcd_barrier(xbar); PE(10); } } while (0)
    for (int l = 0; l < NLAYER; ++l) {
        const int pb = l * 10;
        int tid = threadIdx.x; asm volatile("" : "+v"(tid));
        const int lane = tid & 63, wave = __builtin_amdgcn_readfirstlane(tid >> 6);
        const int gw = c * 8 + wave, NGW = G * 8, gtid = c * 512 + tid, NT = G * 512;
        const float* xin = (l == 0) ? P.in[0] : P.out;
        if (IN(pb + 0)) {
            PB(0); WSL();
            convert_weights(P, l, lds, gw, NGW, wave, lane);
            rms_rows(xin, P.in[1] + (size_t)l * DM, s0, gw, NGW, lane);
            PE(0);
        }
        SEAM(pb + 0);
        if (IN(pb + 1)) {
            PB(1); WSL();
            using C1 = pg8::Cfg<MTOK, 5120, DM, DM, DM>;
            pg8::EpiInProj E{s1, s5, (LAS float*)(lds + 131072 + 1024), P.in[13] + (size_t)l * HD, P.in[14] + (size_t)l * HD};
            pg8::gemm_phase<C1>(lds, s0, Win, G, c, E);
            PE(1);
        }
        SEAM(pb + 1);
        if (IN(pb + 2)) {
            PB(2); WSL();
            lru_phase(P, l, lds, s2, G, c);
            { using C2 = pg8::Cfg<MTOK, DM, 256, DM, 256, 1, 256>;
              int tid2 = threadIdx.x; asm volatile("" : "+v"(tid2));
              pg8::Unit uu;
              for (int i = 0; pg8::next_unit<C2>(i, G, c, uu); ++i) pool_tile(s6, s1, uu.pm, uu.pn, tid2);
              __syncthreads();
              using CW = pg8::Cfg<DM, DM, 256, DM, 256, 1, 256>;
              pg8::EpiColOp<2> E{(bf16_t*)(wsl + W_EFF), DM, nullptr};
              pg8::gemm_phase<CW>(lds, Wbr, Wpool, G, c, E); }
            attn_phase(lds, s3, s4, s5, G, c);
            PE(2);
        }
        SEAM(pb + 2);
        if (IN(pb + 4)) {
            PB(4); WSL();
            pg8::EpiGateMerge E{s4 + (size_t)c * 131072, s6 + (size_t)c * 65536, s5, P.in[3] + (size_t)l * 3 * DM};
            pg8::gemm_phase<pg8::CfgGM>(lds, s0, (const bf16_t*)wsl, G, c, E);
            PE(4);
        }
        SEAM(pb + 4);
        if (IN(pb + 6)) {
            PB(6); WSL();
            using C5 = pg8::Cfg<MTOK, DM, DM, DM, DM>;
            pg8::EpiResid E{xin, P.out};
            pg8::gemm_phase<C5>(lds, s5, Wout, G, c, E);
            PE(6);
        }
        SEAM(pb + 6);
        if (IN(pb + 7)) { PB(7); WSL(); rms_rows(P.out, P.in[17] + (size_t)l * DM, s0, gw, NGW, lane); PE(7); }
        SEAM(pb + 7);
        if (IN(pb + 8)) {
            PB(8); WSL();
            using C6 = pg8::Cfg<MTOK, NGU, DM, DM, DM>;
            pg8::EpiSwiglu E{s3};
            pg8::gemm_phase<C6>(lds, s0, Wgu, G, c, E);
            PE(8);
        }
        SEAM(pb + 8);
        if (IN(pb + 9)) {
            PB(9); WSL();
            using C7 = pg8::Cfg<MTOK, DM, DFF, DFF, DFF>;
            pg8::EpiResid E{P.out, P.out};
            pg8::gemm_phase<C7>(lds, s3, Wdown, G, c, E);
            PE(9);
        }
        SEAM(pb + 9);
    }
    if (P.dbg >= 0) {
        asm volatile("s_waitcnt vmcnt(0) lgkmcnt(0)" ::: "memory"); grid.sync(); __builtin_amdgcn_fence(__ATOMIC_ACQUIRE, "agent"); asm volatile("s_waitcnt vmcnt(0)" ::: "memory");
        WSL(); const bf16_t* sl = s0 + (size_t)P.dbg * SLOT_ELEMS;
        for (size_t i = (size_t)c * 512 + threadIdx.x; i < (size_t)MTOK * DM; i += (size_t)G * 512) { float v = __uint_as_float((unsigned)sl[i] << 16) + DBG_ADD; if (!(fabsf(v) < 1e30f)) v = 12345.0f; P.out[i] = v; }
    }
#undef IN
#undef SEAM
#undef s0
#undef s1
#undef s2
#undef s3
#undef s4
#undef s5
#undef s6
#undef Win
#undef Wpool
#undef Wbr
#undef Wout
#undef Wgu
#undef Wdown
}

extern "C" void kernel_launch(void* const* d_in, const int* in_sizes, int n_in, void* d_out, int out_size, void* d_ws, size_t ws_size, hipStream_t stream) {
    static int grid = 0;
    if (grid == 0) {
        if (n_in != 21 || ws_size < WS_NEED) { fprintf(stderr, "kernel_launch: unexpected n_in %d / ws_size %zu (need %zu)\n", n_in, ws_size, (size_t)WS_NEED); grid = -1; return; }
        int dev = 0, cus = 0, per_cu = 0;
        hipGetDevice(&dev); hipDeviceGetAttribute(&cus, hipDeviceAttributeMultiprocessorCount, dev);
        if (hipFuncSetAttribute((const void*)mega, hipFuncAttributeMaxDynamicSharedMemorySize, LDS_BYTES) != hipSuccess) { fprintf(stderr, "kernel_launch: hipFuncSetAttribute failed\n"); grid = -1; return; }
        if (hipOccupancyMaxActiveBlocksPerMultiprocessor(&per_cu, (const void*)mega, 512, LDS_BYTES) != hipSuccess || per_cu < 1) { fprintf(stderr, "kernel_launch: occupancy query gave %d\n", per_cu); per_cu = 1; }
        (void)hipGetLastError();
        grid = cus * per_cu;
    }
    if (grid < 0) return;
    if (hipMemsetAsync((char*)d_ws + WS_CTL, 0, CTL_BYTES, stream) != hipSuccess) { fprintf(stderr, "kernel_launch: memset failed\n"); return; }
    Params p{};
    for (int i = 0; i < 21; ++i) p.in[i] = (const float*)d_in[i];
    p.out = (float*)d_out; p.ws = (unsigned char*)d_ws; p.lo = 0; p.hi = DBG_HI; p.dbg = DBG_SLOT;
    void* args[] = {&p};
    hipError_t e = hipLaunchCooperativeKernel((const void*)mega, dim3(grid), dim3(512), args, LDS_BYTES, stream);
    if (e != hipSuccess) fprintf(stderr, "cooperative launch failed: %s (grid %d)\n", hipGetErrorString(e), grid);
}
```

```cpp
#include <hip/hip_runtime.h>
#include <hip/hip_cooperative_groups.h>
#include <cstdio>
#include <cstdint>
namespace cg = cooperative_groups;

#define LAS __attribute__((address_space(3)))
typedef unsigned short bf16_t;
typedef short bf16x8 __attribute__((ext_vector_type(8)));
typedef float f32x4 __attribute__((ext_vector_type(4)));
typedef float f32x16 __attribute__((ext_vector_type(16)));
typedef unsigned u32x4 __attribute__((ext_vector_type(4)));
typedef unsigned u32x2 __attribute__((ext_vector_type(2)));

constexpr int BATCH = 16, SEQ = 2048, DM = 1024, MTOK = BATCH * SEQ, NH = 8, HD = 128, DFF = 2816, NGU = 2 * DFF, NLAYER = 2;
constexpr float EPS = 1e-6f;
#ifndef DBG_HI
#define DBG_HI 20
#define DBG_ADD 0.f
#define DBG_SLOT (-1)
#define DBG_OUT_OFF 0
#endif
constexpr size_t MiB = 1u << 20;
constexpr size_t SLOT_BYTES = 64 * MiB, SLOT_ELEMS = SLOT_BYTES / 2;
constexpr size_t W_IN = 0, W_POOL = 16 * MiB, W_BR = W_POOL + MiB / 2, W_OUT = W_BR + 6 * MiB, W_GU = W_OUT + 2 * MiB, W_DOWN = W_GU + 11 * MiB;
constexpr size_t SLOT0 = 42 * MiB;
static_assert(W_DOWN + (size_t)DM * DFF * 2 <= SLOT0, "weight map");
constexpr size_t WS_CTL = SLOT0 + 7 * SLOT_BYTES;
constexpr size_t CTL_BYTES = 16384;
constexpr size_t W_EFF = WS_CTL + 1 * MiB;
constexpr size_t WS_NEED = W_EFF + 2 * MiB;
constexpr int LDS_BYTES = 147456;

typedef __bf16 bf16v2_t __attribute__((ext_vector_type(2)));
typedef float f32v2_t __attribute__((ext_vector_type(2)));
__device__ __forceinline__ unsigned cvt_pk_bf16(float lo, float hi) { const f32v2_t f = {lo, hi}; const bf16v2_t v = __builtin_convertvector(f, bf16v2_t); return __builtin_bit_cast(unsigned, v); }
__device__ __forceinline__ float bf_lo(unsigned u) { return __uint_as_float(u << 16); }
__device__ __forceinline__ float bf_hi(unsigned u) { return __uint_as_float(u & 0xffff0000u); }
__device__ __forceinline__ float fast_sigmoid(float x) { return __builtin_amdgcn_rcpf(1.0f + __expf(-x)); }
__device__ __forceinline__ float wave_sum(float v) {
#pragma unroll
    for (int o = 1; o < 64; o <<= 1) v += __shfl_xor(v, o);
    return v;
}

namespace pg8 {
constexpr int BM = 256, BK = 64, HALF = 128, HTB = HALF * BK * 2, STAGE_BYTES = 8 * HTB, NXCD = 8, WGM = 8;
__host__ __device__ __forceinline__ int lds_byte(int r, int c) { const int st = (r >> 4) * 2 + (c >> 5), rr = r & 15, cc = c & 31, ob = rr * 64 + cc * 2; return st * 1024 + (ob ^ (((ob >> 9) & 1) << 5)); }
__host__ __device__ __forceinline__ void stage_rc(int b, int& R, int& C) { const int st = b / 1024, sb = b % 1024, swz = sb ^ (((sb >> 9) & 1) << 5); R = (st >> 1) * 16 + swz / 64; C = (st & 1) * 32 + (swz % 64) / 2; }
__host__ __device__ __forceinline__ int perm32(int rho) { const int n = rho >> 4, i = rho & 15; return 8 * (i >> 2) + 4 * n + (i & 3); }

struct Unit { int pm, pn, z; };
template <int M_, int N_, int K_, int LDA_, int LDB_, int NZ_ = 1, int APN_ = 0, long AZ_ = 0, long BZ_ = 0>
struct Cfg { static constexpr int nM = M_ / BM, nN = N_ / BM, nwg = nM * nN, K = K_, LDA = LDA_, LDB = LDB_, NZ = NZ_, APN = APN_; static constexpr long AZ = AZ_, BZ = BZ_;
    static __device__ __forceinline__ size_t aoff(const Unit& u) { return (size_t)u.z * AZ + (size_t)u.pm * (BM * LDA) + (size_t)u.pn * APN; }
    static __device__ __forceinline__ size_t boff(const Unit& u) { return (size_t)u.z * BZ + (size_t)u.pn * (BM * LDB); }
    static __device__ __forceinline__ void fix(Unit&) {} };
struct CfgGM { static constexpr int nM = MTOK / BM, nN = DM / BM, nwg = nM * nN, K = DM, LDA = DM, LDB = DM, NZ = 6;
    static __device__ __forceinline__ void fix(Unit& u) { const int z6 = u.z; u.z = (z6 < 3) ? 2 * z6 : 2 * (z6 - 3) + 1; }
    static __device__ __forceinline__ size_t aoff(const Unit& u) { return ((u.z & 1) ? (size_t)(1 + (u.z >> 1)) * SLOT_ELEMS : (size_t)0) + (size_t)u.pm * (BM * DM); }
    static __device__ __forceinline__ size_t boff(const Unit& u) { return ((u.z & 1) ? ((u.z == 1) ? (size_t)(W_EFF / 2) : (size_t)(W_BR / 2) + (size_t)(u.z >> 1) * DM * DM) : (size_t)(5120 + (u.z >> 1) * DM) * DM) + (size_t)u.pn * (BM * DM); } };
template <class C>
__device__ __forceinline__ bool next_unit(int i, int G, int c, Unit& u) {
    const int round = i / C::NZ; u.z = i - round * C::NZ;
    const int L = round * G + c; if (L >= C::nwg) return false;
    int wgid = L; { constexpr int q = C::nwg / NXCD, r = C::nwg % NXCD; const int xcd = wgid % NXCD, off = wgid / NXCD; wgid = (xcd < r ? xcd * (q + 1) : r * (q + 1) + (xcd - r) * q) + off; }
    constexpr int nig = WGM * C::nN; const int gid = wgid / nig, fm = gid * WGM, gsz = (C::nM - fm) < WGM ? (C::nM - fm) : WGM;
    u.pm = fm + ((wgid % nig) % gsz); u.pn = (wgid % nig) / gsz; C::fix(u); return true;
}

template <class C, class Epi>
__device__ __forceinline__ void gemm_phase(LAS unsigned char* lds, const bf16_t* gA, const bf16_t* gBt, const int G, const int c, const Epi& E) {
    int tid = threadIdx.x; asm volatile("" : "+v"(tid));
    const int wid = __builtin_amdgcn_readfirstlane(tid >> 6), lane = tid & 63, wr = wid >> 2, wc = wid & 3, fr = lane & 15, fq = lane >> 4;
    constexpr int nt = C::K / BK;
    unsigned voffA[2], voffB[2];
#pragma unroll
    for (int i = 0; i < 2; ++i) { int R, Cc; stage_rc(tid * 16 + i * 8192, R, Cc); const int Rb = Epi::PERM ? ((R & ~31) + perm32(R & 31)) : R;
        voffA[i] = (unsigned)(R * C::LDA + Cc) * 2u; voffB[i] = (unsigned)(Rb * C::LDB + Cc) * 2u; }
    constexpr unsigned kstep = BK * 2;
    constexpr unsigned hstepA = HALF * C::LDA * 2, hstepB = HALF * C::LDB * 2;
    const unsigned ldsw = (unsigned)wid * 1024u;
    const int aoff = lds_byte(wr * 64 + fr, fq * 8), boff = lds_byte(wc * 32 + fr, fq * 8);
#define PG8_APTR(u) ((const char*)gA + C::aoff(u) * 2)
#define PG8_BPTR(u) ((const char*)gBt + C::boff(u) * 2)
#define PG8_SA(b, h) (((b) * 2 + (h)) * HTB)
#define PG8_SB(b, h) ((4 + (b) * 2 + (h)) * HTB)
#define PG8_STAGE(bufoff, gbase, voff) do { _Pragma("unroll") for (int _i = 0; _i < 2; ++_i) \
        __builtin_amdgcn_global_load_lds((const unsigned*)((const char*)(gbase) + (voff)[_i]), (LAS unsigned*)(lds + (bufoff) + ldsw + _i * 8192), 16, 0, 0); } while (0)
#define PG8_LDA(dst, b, h) do { _Pragma("unroll") for (int m = 0; m < 4; ++m) _Pragma("unroll") for (int k = 0; k < 2; ++k) dst[m][k] = *(const LAS bf16x8*)(lds + PG8_SA(b, h) + aoff + m * 2048 + k * 1024); } while (0)
#define PG8_LDB(dst, b, h) do { _Pragma("unroll") for (int n = 0; n < 2; ++n) _Pragma("unroll") for (int k = 0; k < 2; ++k) dst[n][k] = *(const LAS bf16x8*)(lds + PG8_SB(b, h) + boff + n * 2048 + k * 1024); } while (0)
#define PG8_MMA(ai, bj, At, Bt) do { __builtin_amdgcn_s_setprio(1); _Pragma("unroll") for (int m = 0; m < 4; ++m) _Pragma("unroll") for (int n = 0; n < 2; ++n) _Pragma("unroll") for (int k = 0; k < 2; ++k) \
        acc[ai][bj][m][n] = __builtin_amdgcn_mfma_f32_16x16x32_bf16(Bt[n][k], At[m][k], acc[ai][bj][m][n], 0, 0, 0); __builtin_amdgcn_s_setprio(0); } while (0)
#define PG8_WAIT_V(n) asm volatile("s_waitcnt vmcnt(" #n ")" ::: "memory")
#define PG8_WAIT_L(n) asm volatile("s_waitcnt lgkmcnt(" #n ")" ::: "memory")
#define PG8_BAR __builtin_amdgcn_s_barrier()
#define PG8_SCHED __builtin_amdgcn_sched_barrier(0)
    Unit cur, nxt; int ui = 0;
    if (!next_unit<C>(0, G, c, cur)) return;
    f32x4 acc[2][2][4][2];
#pragma unroll
    for (int a = 0; a < 2; ++a)
#pragma unroll
        for (int b = 0; b < 2; ++b)
#pragma unroll
            for (int m = 0; m < 4; ++m)
#pragma unroll
                for (int n = 0; n < 2; ++n) acc[a][b][m][n] = (f32x4){0.f, 0.f, 0.f, 0.f};
    bf16x8 At[4][2], B0[2][2], B1[2][2];
    const char* cA = PG8_APTR(cur); const char* cB = PG8_BPTR(cur);
    PG8_STAGE(PG8_SB(0, 0), cB, voffB); PG8_STAGE(PG8_SB(0, 1), cB + hstepB, voffB); PG8_STAGE(PG8_SA(0, 0), cA, voffA); PG8_STAGE(PG8_SA(0, 1), cA + hstepA, voffA);
    if (wr == 1) PG8_BAR;
    PG8_WAIT_V(2); PG8_BAR;
    PG8_STAGE(PG8_SB(1, 0), cB + kstep, voffB); PG8_STAGE(PG8_SA(1, 0), cA + kstep, voffA); PG8_STAGE(PG8_SB(1, 1), cB + hstepB + kstep, voffB);
    PG8_WAIT_V(6); PG8_BAR;
    for (;;) {
        const bool has_next = next_unit<C>(ui + 1, G, c, nxt);
        const char* nA = has_next ? PG8_APTR(nxt) : cA; const char* nB = has_next ? PG8_BPTR(nxt) : cB;
#pragma nounroll
        for (int t = 0; t < nt; t += 2) {
            const bool last = (t == nt - 2);
            const char* a1 = cA + (t + 1) * kstep;
            const char* a2 = last ? nA : cA + (t + 2) * kstep; const char* b2 = last ? nB : cB + (t + 2) * kstep;
            const char* a3 = a2 + kstep; const char* b3 = b2 + kstep;
            PG8_LDB(B0, 0, 0); PG8_LDB(B1, 0, 1); PG8_SCHED; PG8_LDA(At, 0, 0); PG8_STAGE(PG8_SA(1, 1), a1 + hstepA, voffA);
            PG8_WAIT_V(8); PG8_WAIT_L(0); PG8_BAR; PG8_MMA(0, 0, At, B0); PG8_MMA(0, 1, At, B1); PG8_BAR; PG8_SCHED;
            PG8_LDA(At, 0, 1); PG8_STAGE(PG8_SB(0, 0), b2, voffB); PG8_STAGE(PG8_SB(0, 1), b2 + hstepB, voffB); PG8_STAGE(PG8_SA(0, 0), a2, voffA);
            PG8_WAIT_V(8); PG8_WAIT_L(0); PG8_BAR; PG8_MMA(1, 0, At, B0); PG8_MMA(1, 1, At, B1); PG8_BAR; PG8_SCHED;
            PG8_LDB(B0, 1, 0); PG8_LDB(B1, 1, 1); PG8_SCHED; PG8_LDA(At, 1, 0); PG8_STAGE(PG8_SA(0, 1), a2 + hstepA, voffA);
            PG8_WAIT_V(8); PG8_WAIT_L(0); PG8_BAR; PG8_MMA(0, 0, At, B0); PG8_MMA(0, 1, At, B1); PG8_BAR; PG8_SCHED;
            PG8_LDA(At, 1, 1); PG8_STAGE(PG8_SB(1, 0), b3, voffB); PG8_STAGE(PG8_SB(1, 1), b3 + hstepB, voffB); PG8_STAGE(PG8_SA(1, 0), a3, voffA);
            PG8_WAIT_V(8); PG8_WAIT_L(0); PG8_BAR; PG8_MMA(1, 0, At, B0); PG8_MMA(1, 1, At, B1); PG8_BAR; PG8_SCHED;
        }
        if (wr == 0) PG8_BAR;
        E(acc, cur, wr, wc, fr, fq);
        if (!has_next) break;
#pragma unroll
        for (int a = 0; a < 2; ++a)
#pragma unroll
            for (int b = 0; b < 2; ++b)
#pragma unroll
                for (int m = 0; m < 4; ++m)
#pragma unroll
                    for (int n = 0; n < 2; ++n) acc[a][b][m][n] = (f32x4){0.f, 0.f, 0.f, 0.f};
        cur = nxt; cA = nA; cB = nB; ++ui;
        if (wr == 1) PG8_BAR;
    }
    PG8_WAIT_V(0);
    PG8_BAR;
#undef PG8_APTR
#undef PG8_BPTR
#undef PG8_SA
#undef PG8_SB
#undef PG8_STAGE
#undef PG8_LDA
#undef PG8_LDB
#undef PG8_MMA
#undef PG8_WAIT_V
#undef PG8_WAIT_L
#undef PG8_BAR
#undef PG8_SCHED
}

typedef f32x4 Acc[2][2][4][2];

struct EpiInProj {
    static constexpr bool PERM = true;
    bf16_t* base; bf16_t* vT; LAS float* X; const float* qg; const float* kg;
    __device__ __forceinline__ void operator()(const Acc& acc, const Unit& u, int wr, int wc, int fr, int fq) const {
        asm volatile("" : "+v"(fr), "+v"(fq));
        const int row0 = u.pm * BM + wr * 64 + fr;
        if (u.pn >= 8 && u.pn < 16) {
            bf16_t* dst = base + (size_t)(u.pn >> 2) * SLOT_ELEMS; const int col0 = (u.pn & 3) * 256 + wc * 32 + 8 * fq;
#pragma unroll
            for (int ai = 0; ai < 2; ++ai)
#pragma unroll
                for (int m = 0; m < 4; ++m)
#pragma unroll
                    for (int bj = 0; bj < 2; ++bj) { const f32x4 v0 = acc[ai][bj][m][0], v1 = acc[ai][bj][m][1];
                        float s = ((v0[0] * v0[0] + v0[1] * v0[1]) + (v0[2] * v0[2] + v0[3] * v0[3])) + ((v1[0] * v1[0] + v1[1] * v1[1]) + (v1[2] * v1[2] + v1[3] * v1[3]));
                        s += __shfl_xor(s, 16); s += __shfl_xor(s, 32);
                        if (fq == 0) X[((wr * 4 + wc) * 16 + (ai * 4 + m) * 2 + bj) * 16 + fr] = s; asm volatile("" ::: "memory"); }
            asm volatile("s_waitcnt lgkmcnt(0)" ::: "memory"); __builtin_amdgcn_s_barrier(); asm volatile("" ::: "memory");
            const float* gsrc = ((u.pn < 12) ? qg : kg) + wc * 32 + 8 * fq;
            const f32x4 g0 = *(const f32x4*)gsrc, g1 = *(const f32x4*)(gsrc + 4);
#pragma unroll
            for (int ai = 0; ai < 2; ++ai)
#pragma unroll
                for (int m = 0; m < 4; ++m) { bf16_t* rowp = dst + (size_t)(row0 + ai * HALF + m * 16) * DM + col0;
#pragma unroll
                    for (int bj = 0; bj < 2; ++bj) { const int xi = ((ai * 4 + m) * 2 + bj) * 16 + fr;
                        const float tot = (X[(wr * 4 + 0) * 256 + xi] + X[(wr * 4 + 1) * 256 + xi]) + (X[(wr * 4 + 2) * 256 + xi] + X[(wr * 4 + 3) * 256 + xi]);
                        const float rstd = rsqrtf(tot * (1.f / HD) + EPS);
                        const f32x4 v0 = acc[ai][bj][m][0] * rstd * g0, v1 = acc[ai][bj][m][1] * rstd * g1; u32x4 w;
                        w.x = cvt_pk_bf16(v0[0], v0[1]); w.y = cvt_pk_bf16(v0[2], v0[3]); w.z = cvt_pk_bf16(v1[0], v1[1]); w.w = cvt_pk_bf16(v1[2], v1[3]);
                        *(u32x4*)(rowp + bj * HALF) = w; asm volatile("" ::: "memory"); } }
        } else if (u.pn < 8) {
            bf16_t* dst = base + (size_t)((u.pn >> 2) ? 1 : 5) * SLOT_ELEMS; const int col0 = (u.pn & 3) * 256 + wc * 32 + 8 * fq;
#pragma unroll
            for (int ai = 0; ai < 2; ++ai)
#pragma unroll
                for (int m = 0; m < 4; ++m) { bf16_t* rowp = dst + (size_t)(row0 + ai * HALF + m * 16) * DM + col0;
#pragma unroll
                    for (int bj = 0; bj < 2; ++bj) { const f32x4 v0 = acc[ai][bj][m][0], v1 = acc[ai][bj][m][1]; u32x4 w;
                        w.x = cvt_pk_bf16(v0[0], v0[1]); w.y = cvt_pk_bf16(v0[2], v0[3]); w.z = cvt_pk_bf16(v1[0], v1[1]); w.w = cvt_pk_bf16(v1[2], v1[3]);
                        *(u32x4*)(rowp + bj * HALF) = w; } }
        } else {
            LAS unsigned char* Wb = (LAS unsigned char*)X + (wr * 4 + wc) * 1024;
            const int lane_ = fq * 16 + fr, dr = lane_ >> 1, hf = lane_ & 1;
#pragma unroll
            for (int ai = 0; ai < 2; ++ai)
#pragma unroll
                for (int m = 0; m < 4; ++m) { const int rowb = u.pm * BM + wr * 64 + ai * HALF + m * 16; const int b = rowb >> 11, s0 = rowb & 2047;
#pragma unroll
                    for (int bj = 0; bj < 2; ++bj) { const int head = (u.pn - 16) * 2 + bj;
                        asm volatile("" ::: "memory");
#pragma unroll
                        for (int n = 0; n < 2; ++n) { const f32x4 v = acc[ai][bj][m][n];
                            const unsigned w0 = cvt_pk_bf16(v[0], v[1]), w1 = cvt_pk_bf16(v[2], v[3]);
                            LAS unsigned short* wp = (LAS unsigned short*)(Wb + (8 * fq + 4 * n) * 32 + fr * 2);
                            wp[0] = (unsigned short)(w0 & 0xffffu); wp[16] = (unsigned short)(w0 >> 16); wp[32] = (unsigned short)(w1 & 0xffffu); wp[48] = (unsigned short)(w1 >> 16); }
                        asm volatile("s_waitcnt lgkmcnt(0)" ::: "memory");
                        const u32x4 t4 = *(const LAS u32x4*)(Wb + dr * 32 + hf * 16);
                        *(u32x4*)(vT + ((size_t)((b * NH + head) * HD + wc * 32 + dr)) * SEQ + s0 + hf * 8) = t4;
                        asm volatile("s_waitcnt lgkmcnt(0)" ::: "memory"); } }
        }
    }
};
template <int MODE> struct EpiColOp {
    static constexpr bool PERM = true;
    bf16_t* O; int ldc; const float* vec;
    __device__ __forceinline__ void operator()(const Acc& acc, const Unit& u, int wr, int wc, int fr, int fq) const {
        const int row0 = u.pm * BM + wr * 64 + fr, col0 = u.pn * BM + wc * 32 + 8 * fq;
        f32x4 bv[2][2];
#pragma unroll
        for (int bj = 0; bj < 2; ++bj)
#pragma unroll
            for (int n = 0; n < 2; ++n) bv[bj][n] = (MODE == 2) ? (f32x4){1.f, 1.f, 1.f, 1.f} : *(const f32x4*)(vec + col0 + bj * HALF + 4 * n);
#pragma unroll
        for (int ai = 0; ai < 2; ++ai)
#pragma unroll
            for (int m = 0; m < 4; ++m) { bf16_t* rowp = O + (size_t)(row0 + ai * HALF + m * 16) * ldc + col0;
#pragma unroll
                for (int bj = 0; bj < 2; ++bj) { f32x4 v0 = acc[ai][bj][m][0], v1 = acc[ai][bj][m][1];
                    if (MODE == 0) { v0 = v0 + bv[bj][0]; v1 = v1 + bv[bj][1];
#pragma unroll
                        for (int j = 0; j < 4; ++j) { v0[j] = fast_sigmoid(v0[j]); v1[j] = fast_sigmoid(v1[j]); } }
                    else { v0 = v0 * bv[bj][0]; v1 = v1 * bv[bj][1]; }
                    u32x4 w; w.x = cvt_pk_bf16(v0[0], v0[1]); w.y = cvt_pk_bf16(v0[2], v0[3]); w.z = cvt_pk_bf16(v1[0], v1[1]); w.w = cvt_pk_bf16(v1[2], v1[3]);
                    *(u32x4*)(rowp + bj * HALF) = w; } }
    }
};
struct EpiMerge {
    static constexpr bool PERM = true;
    const bf16_t* gates; bf16_t* merged;
    __device__ __forceinline__ void operator()(const Acc& acc, const Unit& u, int wr, int wc, int fr, int fq) const {
        const int row0 = u.pm * BM + wr * 64 + fr, col0 = u.pn * BM + wc * 32 + 8 * fq;
#pragma unroll
        for (int ai = 0; ai < 2; ++ai)
#pragma unroll
            for (int m = 0; m < 4; ++m) { const size_t row = (size_t)(row0 + ai * HALF + m * 16);
#pragma unroll
                for (int bj = 0; bj < 2; ++bj) { const int col = col0 + bj * HALF;
                    const u32x4 gv = *(const u32x4*)(gates + row * (3 * DM) + u.z * DM + col);
                    u32x4 pv = (u32x4){0u, 0u, 0u, 0u}; if (u.z > 0) pv = *(const u32x4*)(merged + row * DM + col);
                    const f32x4 v0 = acc[ai][bj][m][0], v1 = acc[ai][bj][m][1]; u32x4 w;
                    w.x = cvt_pk_bf16(bf_lo(pv.x) + bf_lo(gv.x) * v0[0], bf_hi(pv.x) + bf_hi(gv.x) * v0[1]);
                    w.y = cvt_pk_bf16(bf_lo(pv.y) + bf_lo(gv.y) * v0[2], bf_hi(pv.y) + bf_hi(gv.y) * v0[3]);
                    w.z = cvt_pk_bf16(bf_lo(pv.z) + bf_lo(gv.z) * v1[0], bf_hi(pv.z) + bf_hi(gv.z) * v1[1]);
                    w.w = cvt_pk_bf16(bf_lo(pv.w) + bf_lo(gv.w) * v1[2], bf_hi(pv.w) + bf_hi(gv.w) * v1[3]);
                    *(u32x4*)(merged + row * DM + col) = w; } }
    }
};
struct EpiGateMerge {
    static constexpr bool PERM = true;
    bf16_t* scr01; bf16_t* scr2; bf16_t* merged; const float* bgate;
    __device__ __forceinline__ void operator()(const Acc& acc, const Unit& u, int wr, int wc, int fr, int fq) const {
        asm volatile("" : "+v"(fr), "+v"(fq));
        const int lrow0 = wr * 64 + fr, lcol0 = wc * 32 + 8 * fq;
        bf16_t* scratch = ((u.z >> 1) < 2) ? scr01 + (u.z >> 1) * 65536 : scr2;
        if (!(u.z & 1)) {
            const float* bp = bgate + (u.z >> 1) * DM + u.pn * BM + lcol0;
            f32x4 bv[2][2];
#pragma unroll
            for (int bj = 0; bj < 2; ++bj)
#pragma unroll
                for (int n = 0; n < 2; ++n) bv[bj][n] = *(const f32x4*)(bp + bj * HALF + 4 * n);
#pragma unroll
            for (int ai = 0; ai < 2; ++ai)
#pragma unroll
                for (int m = 0; m < 4; ++m) { bf16_t* rowp = scratch + (lrow0 + ai * HALF + m * 16) * 256 + lcol0;
#pragma unroll
                    for (int bj = 0; bj < 2; ++bj) { f32x4 v0 = acc[ai][bj][m][0] + bv[bj][0], v1 = acc[ai][bj][m][1] + bv[bj][1];
#pragma unroll
                        for (int j = 0; j < 4; ++j) { v0[j] = fast_sigmoid(v0[j]); v1[j] = fast_sigmoid(v1[j]); }
                        u32x4 w; w.x = cvt_pk_bf16(v0[0], v0[1]); w.y = cvt_pk_bf16(v0[2], v0[3]); w.z = cvt_pk_bf16(v1[0], v1[1]); w.w = cvt_pk_bf16(v1[2], v1[3]);
                        *(u32x4*)(rowp + bj * HALF) = w; } }
        } else {
#pragma unroll
            for (int ai = 0; ai < 2; ++ai)
#pragma unroll
                for (int m = 0; m < 4; ++m) { const int lrow = lrow0 + ai * HALF + m * 16; bf16_t* mrow = merged + (size_t)(u.pm * BM + lrow) * DM + u.pn * BM + lcol0;
#pragma unroll
                    for (int bj = 0; bj < 2; ++bj) {
                        const u32x4 gv = *(const u32x4*)(scratch + lrow * 256 + lcol0 + bj * HALF);
                        u32x4 pv = (u32x4){0u, 0u, 0u, 0u}; if (u.z > 1) pv = *(const u32x4*)(mrow + bj * HALF);
                        const f32x4 v0 = acc[ai][bj][m][0], v1 = acc[ai][bj][m][1]; u32x4 w;
                        w.x = cvt_pk_bf16(bf_lo(pv.x) + bf_lo(gv.x) * v0[0], bf_hi(pv.x) + bf_hi(gv.x) * v0[1]);
                        w.y = cvt_pk_bf16(bf_lo(pv.y) + bf_lo(gv.y) * v0[2], bf_hi(pv.y) + bf_hi(gv.y) * v0[3]);
                        w.z = cvt_pk_bf16(bf_lo(pv.z) + bf_lo(gv.z) * v1[0], bf_hi(pv.z) + bf_hi(gv.z) * v1[1]);
                        w.w = cvt_pk_bf16(bf_lo(pv.w) + bf_lo(gv.w) * v1[2], bf_hi(pv.w) + bf_hi(gv.w) * v1[3]);
                        *(u32x4*)(mrow + bj * HALF) = w; } }
        }
    }
};
struct EpiResid {
    static constexpr bool PERM = false;
    const float* base; float* out;
    __device__ __forceinline__ void operator()(const Acc& acc, const Unit& u, int wr, int wc, int fr, int fq) const {
        const int row0 = u.pm * BM + wr * 64 + fr, col0 = u.pn * BM + wc * 32 + 4 * fq;
#pragma unroll
        for (int ai = 0; ai < 2; ++ai)
#pragma unroll
            for (int m = 0; m < 4; ++m) { const size_t off = (size_t)(row0 + ai * HALF + m * 16) * DM + col0;
#pragma unroll
                for (int bj = 0; bj < 2; ++bj)
#pragma unroll
                    for (int n = 0; n < 2; ++n) { const f32x4 bs = *(const f32x4*)(base + off + bj * HALF + n * 16);
                        *(f32x4*)(out + off + bj * HALF + n * 16) = bs + acc[ai][bj][m][n]; } }
    }
};
struct EpiSwiglu {
    static constexpr bool PERM = true;
    bf16_t* act;
    __device__ __forceinline__ void operator()(const Acc& acc, const Unit& u, int wr, int wc, int fr, int fq) const {
        const int row0 = u.pm * BM + wr * 64 + fr, col0 = u.pn * 128 + wc * 32 + 8 * fq;
#pragma unroll
        for (int ai = 0; ai < 2; ++ai)
#pragma unroll
            for (int m = 0; m < 4; ++m) { bf16_t* rowp = act + (size_t)(row0 + ai * HALF + m * 16) * DFF + col0;
                f32x4 r0, r1; const f32x4 g0 = acc[ai][0][m][0], g1 = acc[ai][0][m][1], u0 = acc[ai][1][m][0], u1 = acc[ai][1][m][1];
#pragma unroll
                for (int j = 0; j < 4; ++j) { r0[j] = g0[j] * fast_sigmoid(g0[j]) * u0[j]; r1[j] = g1[j] * fast_sigmoid(g1[j]) * u1[j]; }
                u32x4 w; w.x = cvt_pk_bf16(r0[0], r0[1]); w.y = cvt_pk_bf16(r0[2], r0[3]); w.z = cvt_pk_bf16(r1[0], r1[1]); w.w = cvt_pk_bf16(r1[2], r1[3]);
                *(u32x4*)rowp = w; }
    }
};
}

__device__ __forceinline__ void transpose_item(const float* W, int K, int N, bf16_t* WT, int row_off, int mode, LAS float* scr, int item, int lane) {
    const int nblk = N / 32, kb = item / nblk, nb = item % nblk, k0 = 64 * kb, n0 = 32 * nb;
    const float* wp = W + (size_t)(k0 + (lane >> 5)) * N + n0 + (lane & 31);
    float wv[32];
#pragma unroll
    for (int i = 0; i < 32; ++i) wv[i] = wp[(size_t)(2 * i) * N];
#pragma unroll
    for (int i = 0; i < 32; ++i) scr[(2 * i + (lane >> 5)) * 33 + (lane & 31)] = wv[i];
    asm volatile("s_waitcnt lgkmcnt(0)" ::: "memory");
    const int c = lane & 7;
#pragma unroll
    for (int j = 0; j < 4; ++j) { const int n = (lane >> 3) + 8 * j; const LAS float* s = scr + (8 * c) * 33 + n;
        u32x4 o; o.x = cvt_pk_bf16(s[0 * 33], s[1 * 33]); o.y = cvt_pk_bf16(s[2 * 33], s[3 * 33]); o.z = cvt_pk_bf16(s[4 * 33], s[5 * 33]); o.w = cvt_pk_bf16(s[6 * 33], s[7 * 33]);
        const int ng = n0 + n; const int drow = (mode == 0) ? (row_off + ng) : (256 * (ng >> 7) + (ng & 127) + 128 * (mode - 1));
        *(u32x4*)(WT + (size_t)drow * K + k0 + 8 * c) = o; }
    asm volatile("s_waitcnt lgkmcnt(0)" ::: "memory");
}

struct Params { const float* in[21]; float* out; unsigned char* ws; int lo, hi, dbg, pad; };

__device__ __forceinline__ void convert_weights(const Params& P, int l, LAS unsigned char* lds, int gw, int NGW, int wave, int lane) {
    LAS float* scr = (LAS float*)(lds + wave * 16384);
    unsigned char* ws = P.ws;
    constexpr int I_IN = 16 * 256, I_POOL = 4 * 8, I_BR = 16 * 32, I_OUT = 16 * 32, I_G = 16 * 88, I_D = 44 * 32;
    constexpr int NITEMS = I_IN + 4 * I_POOL + 3 * I_BR + I_OUT + 2 * I_G + I_D;
    for (int it = gw; it < NITEMS; it += NGW) {
        int r = it;
        if (r < I_IN) { transpose_item(P.in[2] + (size_t)l * DM * 8192, DM, 8192, (bf16_t*)(ws + W_IN), 0, 0, scr, r, lane); continue; } r -= I_IN;
        if (r < 4 * I_POOL) {
            const int row0 = r * 8;
#pragma unroll
            for (int rr = 0; rr < 8; ++rr) { const int row = row0 + rr; const int g = row >> 8;
                const f32x4 wv4 = *(const f32x4*)(P.in[4] + (size_t)l * 4 * 65536 + (size_t)row * 256 + lane * 4);
                const f32x4 sc4 = *(const f32x4*)(P.in[5] + (size_t)l * DM + g * 256 + lane * 4);
                u32x2 o; o.x = cvt_pk_bf16(wv4[0] * sc4[0], wv4[1] * sc4[1]); o.y = cvt_pk_bf16(wv4[2] * sc4[2], wv4[3] * sc4[3]);
                *(u32x2*)((bf16_t*)(ws + W_POOL) + (size_t)row * 256 + lane * 4) = o; }
            continue; } r -= 4 * I_POOL;
        if (r < 3 * I_BR) { const int b = r / I_BR; transpose_item(P.in[15] + (size_t)(l * 3 + b) * DM * DM, DM, DM, (bf16_t*)(ws + W_BR) + (size_t)b * DM * DM, 0, 0, scr, r % I_BR, lane); continue; } r -= 3 * I_BR;
        if (r < I_OUT) { transpose_item(P.in[16] + (size_t)l * DM * DM, DM, DM, (bf16_t*)(ws + W_OUT), 0, 0, scr, r, lane); continue; } r -= I_OUT;
        if (r < I_G) { transpose_item(P.in[18] + (size_t)l * DM * DFF, DM, DFF, (bf16_t*)(ws + W_GU), 0, 1, scr, r, lane); continue; } r -= I_G;
        if (r < I_G) { transpose_item(P.in[19] + (size_t)l * DM * DFF, DM, DFF, (bf16_t*)(ws + W_GU), 0, 2, scr, r, lane); continue; } r -= I_G;
        transpose_item(P.in[20] + (size_t)l * DFF * DM, DFF, DM, (bf16_t*)(ws + W_DOWN), 0, 0, scr, r, lane);
    }
}

__device__ __forceinline__ void rms_rows(const float* x, const float* g, bf16_t* out, int gw, int NGW, int lane) {
    f32x4 gg[4];
#pragma unroll
    for (int j = 0; j < 4; ++j) gg[j] = ((const f32x4*)g)[64 * j + lane];
    for (int m = gw; m < MTOK; m += 2 * NGW) {
        const int m2 = m + NGW; const bool has2 = m2 < MTOK;
        const f32x4* xr = (const f32x4*)(x + (size_t)m * DM) + lane; const f32x4* xr2 = (const f32x4*)(x + (size_t)(has2 ? m2 : m) * DM) + lane;
        f32x4 v[4], v2[4]; float s = 0.f, s2 = 0.f;
#pragma unroll
        for (int j = 0; j < 4; ++j) { v[j] = xr[64 * j]; v2[j] = xr2[64 * j]; }
#pragma unroll
        for (int j = 0; j < 4; ++j) { s += (v[j][0] * v[j][0] + v[j][1] * v[j][1]) + (v[j][2] * v[j][2] + v[j][3] * v[j][3]); s2 += (v2[j][0] * v2[j][0] + v2[j][1] * v2[j][1]) + (v2[j][2] * v2[j][2] + v2[j][3] * v2[j][3]); }
        const float rstd = rsqrtf(wave_sum(s) * (1.f / DM) + EPS), rstd2 = rsqrtf(wave_sum(s2) * (1.f / DM) + EPS);
        u32x2* o = (u32x2*)(out + (size_t)m * DM) + lane; u32x2* o2 = (u32x2*)(out + (size_t)m2 * DM) + lane;
#pragma unroll
        for (int j = 0; j < 4; ++j) { u32x2 w;
            w.x = cvt_pk_bf16(v[j][0] * rstd * gg[j][0], v[j][1] * rstd * gg[j][1]); w.y = cvt_pk_bf16(v[j][2] * rstd * gg[j][2], v[j][3] * rstd * gg[j][3]); o[64 * j] = w;
            if (has2) { w.x = cvt_pk_bf16(v2[j][0] * rstd2 * gg[j][0], v2[j][1] * rstd2 * gg[j][1]); w.y = cvt_pk_bf16(v2[j][2] * rstd2 * gg[j][2], v2[j][3] * rstd2 * gg[j][3]); o2[64 * j] = w; } }
    }
}

__device__ __forceinline__ void qk_norm_rows(bf16_t* q, bf16_t* k, const float* qg, const float* kg, int gw, int NGW, int lane) {
    const int d0 = (lane & 7) * 16;
    for (int it = gw; it < 2 * MTOK; it += NGW) {
        const int which = it >= MTOK; const int m = it - which * MTOK;
        bf16_t* p = (which ? k : q) + (size_t)m * DM + lane * 16; const float* gg = (which ? kg : qg) + d0;
        const u32x4 a = *(const u32x4*)p, b = *(const u32x4*)(p + 8);
        float v[16];
        v[0] = bf_lo(a.x); v[1] = bf_hi(a.x); v[2] = bf_lo(a.y); v[3] = bf_hi(a.y); v[4] = bf_lo(a.z); v[5] = bf_hi(a.z); v[6] = bf_lo(a.w); v[7] = bf_hi(a.w);
        v[8] = bf_lo(b.x); v[9] = bf_hi(b.x); v[10] = bf_lo(b.y); v[11] = bf_hi(b.y); v[12] = bf_lo(b.z); v[13] = bf_hi(b.z); v[14] = bf_lo(b.w); v[15] = bf_hi(b.w);
        float ss = 0.f;
#pragma unroll
        for (int e = 0; e < 16; ++e) ss += v[e] * v[e];
        ss += __shfl_xor(ss, 1); ss += __shfl_xor(ss, 2); ss += __shfl_xor(ss, 4);
        const float rstd = rsqrtf(ss * (1.f / HD) + EPS);
        unsigned w[8];
#pragma unroll
        for (int e = 0; e < 8; ++e) w[e] = cvt_pk_bf16(v[2 * e] * rstd * gg[2 * e], v[2 * e + 1] * rstd * gg[2 * e + 1]);
        *(u32x4*)p = (u32x4){w[0], w[1], w[2], w[3]}; *(u32x4*)(p + 8) = (u32x4){w[4], w[5], w[6], w[7]};
    }
}

__device__ __forceinline__ void unpack8(const u32x4 a, float (&v)[8]) { v[0] = bf_lo(a.x); v[1] = bf_hi(a.x); v[2] = bf_lo(a.y); v[3] = bf_hi(a.y); v[4] = bf_lo(a.z); v[5] = bf_hi(a.z); v[6] = bf_lo(a.w); v[7] = bf_hi(a.w); }
__device__ __forceinline__ void pool_elem(const bf16_t* u, bf16_t* p, int gtid, int NT) {
    for (int id = gtid; id < BATCH * 128 * 128; id += NT) {
        const int oct = id & 127, strip = (id >> 7) & 127, b = id >> 14;
        const int c0 = oct * 8, w = 2 << (c0 >> 8), t0 = strip * 16;
        const bf16_t* ub = u + (size_t)b * SEQ * DM + c0; bf16_t* pb = p + (size_t)b * SEQ * DM + c0;
        float S[8];
#pragma unroll
        for (int e = 0; e < 8; ++e) S[e] = 0.f;
        for (int k = 1; k <= w; ++k) { const int t = t0 - k; if (t >= 0) { float v[8]; unpack8(*(const u32x4*)(ub + (size_t)t * DM), v);
#pragma unroll
                for (int e = 0; e < 8; ++e) S[e] += v[e]; } }
        for (int i = 0; i < 16; ++i) { const int t = t0 + i; float v[8]; unpack8(*(const u32x4*)(ub + (size_t)t * DM), v);
            if (t - w >= 0) { float o[8]; unpack8(*(const u32x4*)(ub + (size_t)(t - w) * DM), o);
#pragma unroll
                for (int e = 0; e < 8; ++e) S[e] -= o[e]; }
            const float inv = 1.f / (float)((t + 1) < w ? (t + 1) : w); float r[8];
#pragma unroll
            for (int e = 0; e < 8; ++e) { S[e] += v[e]; r[e] = S[e] * inv - v[e]; }
            *(u32x4*)(pb + (size_t)t * DM) = (u32x4){cvt_pk_bf16(r[0], r[1]), cvt_pk_bf16(r[2], r[3]), cvt_pk_bf16(r[4], r[5]), cvt_pk_bf16(r[6], r[7])}; }
    }
}

__device__ __forceinline__ void pool_tile(const bf16_t* u, bf16_t* p, int pm, int g, int tid) {
    const int oct = tid & 31, strip = tid >> 5;
    const int c0 = g * 256 + oct * 8, w = 2 << g, row0 = pm * 256 + strip * 16, b = row0 >> 11, t0 = row0 & 2047;
    const bf16_t* ub = u + (size_t)b * SEQ * DM + c0; bf16_t* pb = p + (size_t)b * SEQ * DM + c0;
    float S[8];
#pragma unroll
    for (int e = 0; e < 8; ++e) S[e] = 0.f;
#pragma unroll 8
    for (int k = 1; k <= 16; ++k) { const int t = t0 - k; if (k <= w && t >= 0) { float v[8]; unpack8(*(const u32x4*)(ub + (size_t)t * DM), v);
#pragma unroll
            for (int e = 0; e < 8; ++e) S[e] += v[e]; } }
#pragma unroll 4
    for (int i = 0; i < 16; ++i) { const int t = t0 + i; float v[8], o[8]; unpack8(*(const u32x4*)(ub + (size_t)t * DM), v);
        const int tl = (t - w >= 0) ? (t - w) : t; unpack8(*(const u32x4*)(ub + (size_t)tl * DM), o);
        const float keep = (t - w >= 0) ? 1.f : 0.f;
        const float inv = 1.f / (float)((t + 1) < w ? (t + 1) : w); float r[8];
#pragma unroll
        for (int e = 0; e < 8; ++e) { S[e] = S[e] - keep * o[e] + v[e]; r[e] = S[e] * inv - v[e]; }
        *(u32x4*)(pb + (size_t)t * DM) = (u32x4){cvt_pk_bf16(r[0], r[1]), cvt_pk_bf16(r[2], r[3]), cvt_pk_bf16(r[4], r[5]), cvt_pk_bf16(r[6], r[7])}; }
}

__device__ __forceinline__ void lru_combine(float& A, float& H, float Ax, float Hx) { H = A * Hx + H; A = A * Ax; }
__device__ __forceinline__ void lru_phase(const Params& P, int l, LAS unsigned char* lds, bf16_t* ulru, int G, int c) {
    int tid = threadIdx.x; asm volatile("" : "+v"(tid));
    const int lane = tid & 63, wave = __builtin_amdgcn_readfirstlane(tid >> 6), l15 = lane & 15, q = lane >> 4;
    LAS float* XC = (LAS float*)lds;
    LAS bf16_t* XCB = (LAS bf16_t*)(lds + 65536);
    LAS float* GT = (LAS float*)(lds + 65536 + 36864);
    LAS bf16x8* WF = (LAS bf16x8*)(lds + 65536 + 36864 + 8192);
    const float* conv_w = P.in[6] + (size_t)l * 4 * DM; const float* conv_b = P.in[7] + (size_t)l * DM;
    const float* w_rg = P.in[8] + (size_t)l * 16 * 4096; const float* b_rg = P.in[9] + (size_t)l * DM;
    const float* w_ig = P.in[10] + (size_t)l * 16 * 4096; const float* b_ig = P.in[11] + (size_t)l * DM;
    const float* lam = P.in[12] + (size_t)l * DM;
    for (int it = c; it < BATCH * 16; it += G) {
        const int b = it >> 4, hb = it & 15, ch0 = hb * 64;
        const int chl = ch0 + lane;
        const float cw0 = conv_w[chl], cw1 = conv_w[DM + chl], cw2 = conv_w[2 * DM + chl], cw3 = conv_w[3 * DM + chl], cb = conv_b[chl];
        float brg[4], big[4], sp8[4], carry[4];
#pragma unroll
        for (int nt = 0; nt < 4; ++nt) { const int ch = ch0 + 16 * nt + l15; brg[nt] = b_rg[ch]; big[nt] = b_ig[ch]; carry[nt] = 0.f;
            const float x = -lam[ch]; sp8[nt] = -8.0f * (fmaxf(x, 0.f) + log1pf(__expf(-fabsf(x)))); }
        bf16_t* ubase = ulru + (size_t)b * SEQ * DM + ch0;
        __syncthreads();
#pragma unroll
        for (int k = 0; k < 4; ++k) { const int idx = tid * 4 + k * 2048;
            const f32x4 wv4 = *(const f32x4*)((idx < 4096 ? w_rg + (size_t)hb * 4096 + idx : w_ig + (size_t)hb * 4096 + (idx - 4096)));
            *(LAS f32x4*)(XC + idx) = wv4; }
        __syncthreads();
#pragma unroll
        for (int nt = 0; nt < 8; ++nt)
#pragma unroll
            for (int ks = 0; ks < 2; ++ks) { const LAS float* wsrc = XC + (nt < 4 ? 0 : 4096) + 16 * (nt & 3) + l15;
                const int k0 = ks * 32 + q * 8; unsigned pk[4];
#pragma unroll
                for (int e = 0; e < 4; ++e) pk[e] = cvt_pk_bf16(wsrc[(k0 + 2 * e) * 64], wsrc[(k0 + 2 * e + 1) * 64]);
                u32x4 t4 = (u32x4){pk[0], pk[1], pk[2], pk[3]};
                WF[(nt * 2 + ks) * 64 + lane] = __builtin_bit_cast(bf16x8, t4); }
        __syncthreads();
        unsigned short pre[35];
#pragma unroll
        for (int i = 0; i < 35; ++i) { const int t = 32 * wave - 3 + i; pre[i] = (t >= 0) ? ubase[(size_t)t * DM + lane] : (unsigned short)0; }
        for (int ck = 0; ck < SEQ / 256; ++ck) {
            const int t0 = ck * 256, par = ck & 1;
            { float uf[35];
#pragma unroll
                for (int i = 0; i < 35; ++i) uf[i] = __uint_as_float((unsigned)pre[i] << 16);
#pragma unroll
                for (int i = 0; i < 32; ++i) { const int t = 32 * wave + i; const float xc = cb + cw0 * uf[i] + cw1 * uf[i + 1] + cw2 * uf[i + 2] + cw3 * uf[i + 3];
                    XC[t * 64 + lane] = xc; XCB[t * 72 + lane] = (bf16_t)(cvt_pk_bf16(xc, 0.f) & 0xffffu); } }
            if (ck + 1 < SEQ / 256) {
#pragma unroll
                for (int i = 0; i < 35; ++i) pre[i] = ubase[(size_t)(t0 + 256 + 32 * wave - 3 + i) * DM + lane]; }
            asm volatile("s_waitcnt lgkmcnt(0)" ::: "memory");
            float Ac[2][4][4], Hl[2][4][4], EA[2][4], EH[2][4], TA0[4], TH0[4];
#pragma unroll
            for (int mt = 0; mt < 2; ++mt) {
                f32x4 ga[8];
                { float zf = 0.f; asm volatile("" : "+v"(zf));
#pragma unroll
                  for (int nt = 0; nt < 8; ++nt) ga[nt] = (f32x4){zf, zf, zf, zf}; }
#pragma unroll
                for (int ks = 0; ks < 2; ++ks) { const bf16x8 af = *(const LAS bf16x8*)(XCB + (wave * 32 + mt * 16 + l15) * 72 + ks * 32 + q * 8);
#pragma unroll
                    for (int nt = 0; nt < 8; ++nt) ga[nt] = __builtin_amdgcn_mfma_f32_16x16x32_bf16(af, WF[(nt * 2 + ks) * 64 + lane], ga[nt], 0, 0, 0); }
#pragma unroll
                for (int nt = 0; nt < 4; ++nt) {
                    float A = 1.f, H = 0.f;
#pragma unroll
                    for (int j = 0; j < 4; ++j) { const int t = wave * 32 + mt * 16 + 4 * q + j, ch = 16 * nt + l15;
                        const float r = fast_sigmoid(ga[nt][j] + brg[nt]), ig = fast_sigmoid(ga[nt + 4][j] + big[nt]);
                        const float log_a = r * sp8[nt]; const float a = __expf(log_a); const float x2 = 2.0f * log_a;
                        const float om = (x2 > -0.02f) ? (-x2 * (1.0f + x2 * (0.5f + x2 * (1.0f / 6.0f + x2 * (1.0f / 24.0f))))) : (1.0f - a * a);
                        const float bb = __builtin_amdgcn_sqrtf(om) * (ig * XC[t * 64 + ch]);
                        H = a * H + bb; A = a * A; Ac[mt][nt][j] = A; Hl[mt][nt][j] = H; }
                    { const float Ax = __shfl_up(A, 16), Hx = __shfl_up(H, 16); if (q >= 1) lru_combine(A, H, Ax, Hx); }
                    { const float Ax = __shfl_up(A, 32), Hx = __shfl_up(H, 32); if (q >= 2) lru_combine(A, H, Ax, Hx); }
                    { const float Ax = __shfl_up(A, 16), Hx = __shfl_up(H, 16); EA[mt][nt] = (q >= 1) ? Ax : 1.f; EH[mt][nt] = (q >= 1) ? Hx : 0.f; }
                    const float TA = __shfl(A, 48 + l15), TH = __shfl(H, 48 + l15);
                    if (mt == 0) { TA0[nt] = TA; TH0[nt] = TH; }
                    else { float WA = TA, WH = TH; lru_combine(WA, WH, TA0[nt], TH0[nt]);
                        if (q == 0) { GT[((par * 8 + wave) * 2 + 0) * 64 + 16 * nt + l15] = WA; GT[((par * 8 + wave) * 2 + 1) * 64 + 16 * nt + l15] = WH; } }
                }
            }
            asm volatile("s_waitcnt vmcnt(0) lgkmcnt(0)" ::: "memory");
            __syncthreads();
#pragma unroll
            for (int nt = 0; nt < 4; ++nt) { const int ch = 16 * nt + l15; float hin = carry[nt], hall = carry[nt];
#pragma unroll
                for (int g2 = 0; g2 < 8; ++g2) { const float ga2 = GT[((par * 8 + g2) * 2 + 0) * 64 + ch], gh2 = GT[((par * 8 + g2) * 2 + 1) * 64 + ch]; hall = ga2 * hall + gh2; if (g2 < wave) hin = hall; }
                carry[nt] = hall;
#pragma unroll
                for (int mt = 0; mt < 2; ++mt) { const float sin_mt = (mt == 0) ? hin : (TA0[nt] * hin + TH0[nt]); const float s = EA[mt][nt] * sin_mt + EH[mt][nt];
#pragma unroll
                    for (int j = 0; j < 4; ++j) { const float h = Ac[mt][nt][j] * s + Hl[mt][nt][j];
                        ubase[(size_t)(t0 + wave * 32 + mt * 16 + 4 * q + j) * DM + ch] = (bf16_t)(cvt_pk_bf16(h, 0.f) & 0xffffu); } } }
        }
    }
}

__device__ __forceinline__ void attn_phase(LAS unsigned char* lds, bf16_t* qn, const bf16_t* kn, const bf16_t* vT, int G, int c) {
    int tid = threadIdx.x; asm volatile("" : "+v"(tid));
    const int lane = tid & 63, w = __builtin_amdgcn_readfirstlane(tid >> 6), l31 = lane & 31, hi = lane >> 5;
    constexpr int KSTR = 272, VSTR = 72, KBYTES = 32 * KSTR, VBYTES = 128 * VSTR, WBYTES = KBYTES + VBYTES;
    LAS unsigned char* Kt = lds + w * WBYTES; LAS unsigned char* Vt = Kt + KBYTES;
    const float scale2 = 0.08838834764831845f * 1.4426950408889634f;
    constexpr int NITEM = BATCH * NH * (SEQ / 32);
    const int kst = (lane >> 4) * KSTR + (lane & 15) * 16, vst = (lane >> 2) * VSTR + (lane & 3) * 16;
    __syncthreads();
    for (int L = c * 8 + w; L < NITEM; L += G * 8) {
        const int qb = (SEQ / 32 - 1) - (L >> 7), bh = L & 127, b = bh >> 3, h = bh & 7;
        const size_t tokbase = (size_t)b * SEQ;
        const int qmin = qb * 32, qrow = qmin + l31;
        bf16x8 qf[8];
        { const bf16_t* qp = qn + (tokbase + qrow) * DM + h * HD + hi * 8;
#pragma unroll
            for (int ks = 0; ks < 8; ++ks) qf[ks] = *(const bf16x8*)(qp + ks * 16); }
        f32x16 O[4];
#pragma unroll
        for (int db = 0; db < 4; ++db)
#pragma unroll
            for (int e = 0; e < 16; ++e) O[db][e] = 0.f;
        float R = 0.f;
        const bf16_t* kbase = kn + tokbase * DM + h * HD + (size_t)(lane >> 4) * DM + (lane & 15) * 8;
        const bf16_t* vbase = vT + ((size_t)((b * NH + h) * HD) + (lane >> 2)) * SEQ + (lane & 3) * 8;
        u32x4 st[8];
#pragma unroll
        for (int i = 0; i < 8; ++i) st[i] = *(const u32x4*)(kbase + (size_t)(qb * 32 + 4 * i) * DM);
        for (int kt = qb; kt >= 0; --kt) {
            const int k0 = kt * 32;
            asm volatile("" ::: "memory");
#pragma unroll
            for (int i = 0; i < 8; ++i) *(LAS u32x4*)(Kt + kst + 4 * i * KSTR) = st[i];
#pragma unroll
            for (int i = 0; i < 8; ++i) st[i] = *(const u32x4*)(vbase + (size_t)(16 * i) * SEQ + k0);
            asm volatile("s_waitcnt lgkmcnt(0)" ::: "memory");
            f32x16 s, s1;
            { float zf = 0.f; asm volatile("" : "+v"(zf));
#pragma unroll
              for (int e = 0; e < 16; ++e) { s[e] = zf; s1[e] = zf; } }
            { bf16x8 kf[8];
#pragma unroll
              for (int ks = 0; ks < 8; ++ks) kf[ks] = *(const LAS bf16x8*)(Kt + l31 * KSTR + (ks * 16 + hi * 8) * 2);
              asm volatile("s_waitcnt lgkmcnt(0)" ::: "memory");
#pragma unroll
              for (int ks = 0; ks < 8; ks += 2) { s = __builtin_amdgcn_mfma_f32_32x32x16_bf16(kf[ks], qf[ks], s, 0, 0, 0);
                  s1 = __builtin_amdgcn_mfma_f32_32x32x16_bf16(kf[ks + 1], qf[ks + 1], s1, 0, 0, 0); } }
#pragma unroll
            for (int e = 0; e < 16; ++e) s[e] += s1[e];
            const bool diag = (kt == qb);
            float ls[16], lk[16];
#pragma unroll
            for (int e = 0; e < 16; ++e) { const float z = s[e] * scale2;
                const float sp = __builtin_amdgcn_logf(1.0f + __builtin_amdgcn_exp2f(-fabsf(z)));
                float lse = fminf(z, 0.f) - sp, lke = lse - z;
                if (diag) { const int key = k0 + 8 * (e >> 2) + 4 * hi + (e & 3); if (key >= qrow) { lke = 0.f; lse = -INFINITY; } }
                ls[e] = lse; lk[e] = lke; }
            float gs[4], gp[4];
#pragma unroll
            for (int bb = 0; bb < 4; ++bb) { gs[bb] = (lk[4 * bb] + lk[4 * bb + 1]) + (lk[4 * bb + 2] + lk[4 * bb + 3]);
                const unsigned gx = __float_as_uint(gs[bb]); const auto pr = __builtin_amdgcn_permlane32_swap(gx, gx, false, false);
                gp[bb] = __uint_as_float(hi ? pr[0] : pr[1]); }
            float wv[16]; float E = R;
#pragma unroll
            for (int bb = 3; bb >= 0; --bb) { float base = hi ? E : E + gp[bb];
                wv[4 * bb + 3] = __builtin_amdgcn_exp2f(ls[4 * bb + 3] + base); base += lk[4 * bb + 3];
                wv[4 * bb + 2] = __builtin_amdgcn_exp2f(ls[4 * bb + 2] + base); base += lk[4 * bb + 2];
                wv[4 * bb + 1] = __builtin_amdgcn_exp2f(ls[4 * bb + 1] + base); base += lk[4 * bb + 1];
                wv[4 * bb + 0] = __builtin_amdgcn_exp2f(ls[4 * bb + 0] + base);
                E += gs[bb] + gp[bb]; }
            R = E;
            asm volatile("" ::: "memory");
#pragma unroll
            for (int i = 0; i < 8; ++i) { LAS unsigned char* d_ = Vt + vst + 16 * i * VSTR;
                *(LAS u32x2*)d_ = (u32x2){st[i].x, st[i].y}; *(LAS u32x2*)(d_ + 8) = (u32x2){st[i].z, st[i].w}; }
            if (kt > 0) {
#pragma unroll
                for (int i = 0; i < 8; ++i) st[i] = *(const u32x4*)(kbase + (size_t)(k0 - 32 + 4 * i) * DM); }
            asm volatile("s_waitcnt lgkmcnt(0)" ::: "memory");
            { u32x4 vb4[2][4];
#pragma unroll
              for (int p = 0; p < 2; ++p)
#pragma unroll
                for (int db = 0; db < 4; ++db) { const LAS unsigned char* vp = Vt + (32 * db + l31) * VSTR + (16 * p + 4 * hi) * 2;
                    const u32x2 v0 = *(const LAS u32x2*)vp, v1 = *(const LAS u32x2*)(vp + 16); vb4[p][db] = (u32x4){v0.x, v0.y, v1.x, v1.y}; }
              asm volatile("s_waitcnt lgkmcnt(0)" ::: "memory");
#pragma unroll
              for (int p = 0; p < 2; ++p) {
                u32x4 pa4 = (u32x4){cvt_pk_bf16(wv[8 * p], wv[8 * p + 1]), cvt_pk_bf16(wv[8 * p + 2], wv[8 * p + 3]), cvt_pk_bf16(wv[8 * p + 4], wv[8 * p + 5]), cvt_pk_bf16(wv[8 * p + 6], wv[8 * p + 7])};
                const bf16x8 pa = __builtin_bit_cast(bf16x8, pa4);
#pragma unroll
                for (int db = 0; db < 4; ++db) O[db] = __builtin_amdgcn_mfma_f32_32x32x16_bf16(pa, __builtin_bit_cast(bf16x8, vb4[p][db]), O[db], 0, 0, 0); } }
            if (__all(R < -150.8f)) break;
        }
#pragma unroll
        for (int db = 0; db < 4; ++db)
#pragma unroll
            for (int e = 0; e < 16; ++e) { const int q = qmin + 8 * (e >> 2) + 4 * hi + (e & 3);
                qn[(tokbase + q) * DM + h * HD + 32 * db + l31] = (bf16_t)(cvt_pk_bf16(O[db][e], 0.f) & 0xffffu); }
    }
}

#define XB_TMO      128
#define XB_XCNT(j)  (256  + 64 * (j))
#define XB_XSUB(j)  (1280 + 64 * (j))
#define XB_XGEN(j)  (2304 + 64 * (j))
#define XB_TOP      3328
#define XB_TOPGEN   3392
#define XCD_BAR_WORDS 3456
#define XB_SPIN_CAP (1u << 18)
__device__ __forceinline__ unsigned xb_ld(unsigned* p)              { return __hip_atomic_load(p, __ATOMIC_RELAXED, __HIP_MEMORY_SCOPE_AGENT); }
__device__ __forceinline__ unsigned xb_add(unsigned* p, unsigned v) { return __hip_atomic_fetch_add(p, v, __ATOMIC_RELAXED, __HIP_MEMORY_SCOPE_AGENT); }
__device__ __forceinline__ unsigned xb_xcc_id() { return (unsigned)__builtin_amdgcn_s_getreg((3 << 11) | 20) & 0xFu; }
#define XB_SPIN(cond, bar) do { unsigned _sp = 0; while (cond) { __builtin_amdgcn_s_sleep(1); \
    if ((++_sp & 255u) == 0u) { if (xb_ld(&(bar)[XB_TMO])) break; if (_sp > XB_SPIN_CAP) { atomicAdd(&(bar)[XB_TMO], 1u); break; } } } } while (0)
struct XcdBarrier { unsigned* bar; unsigned x; volatile LAS unsigned* st; };
__device__ __forceinline__ XcdBarrier xcd_barrier_post(unsigned* bar, volatile LAS unsigned* st) {
    XcdBarrier b; b.bar = bar; b.x = xb_xcc_id(); b.st = st;
    if (threadIdx.x == 0) st[2] = xb_add(&bar[XB_XCNT(b.x)], 1u);
    return b;
}
__device__ __forceinline__ void xcd_barrier_complete(unsigned* bar, unsigned x, unsigned& nloc, unsigned& nx) {
    const unsigned G = gridDim.x * gridDim.y * gridDim.z;
    unsigned sum, cnt, mine, sp = 0u;
    for (;;) {
        sum = 0u; cnt = 0u; mine = 0u;
#pragma unroll
        for (unsigned j = 0; j < 16; ++j) { const unsigned c = xb_ld(&bar[XB_XCNT(j)]); sum += c; cnt += (c > 0u) ? 1u : 0u; mine = (j == x) ? c : mine; }
        if (sum == G) break;
        __builtin_amdgcn_s_sleep(1);
        if ((++sp & 255u) == 0u) { if (xb_ld(&bar[XB_TMO])) break; if (sp > XB_SPIN_CAP) { atomicAdd(&bar[XB_TMO], 1u); break; } }
    }
    nloc = mine > 0u ? mine : 1u; nx = cnt > 0u ? cnt : 1u;
}
__device__ __forceinline__ void xcd_barrier(const XcdBarrier& b) {
    asm volatile("s_waitcnt vmcnt(0)" ::: "memory");
    __syncthreads();
    if (threadIdx.x == 0) {
        unsigned* bar = b.bar; asm volatile("" : "+s"(bar));
        __builtin_amdgcn_s_waitcnt(0);
        unsigned nloc = b.st[0], nx = b.st[1];
        if (nloc == 0u) { xcd_barrier_complete(bar, b.x, nloc, nx); b.st[0] = nloc; b.st[1] = nx; }
        const unsigned old = xb_add(&bar[XB_XSUB(b.x)], 1u);
        const unsigned gen = old / nloc;
        if (old + 1u == (gen + 1u) * nloc) {
            __builtin_amdgcn_fence(__ATOMIC_RELEASE, "agent");
            asm volatile("s_waitcnt vmcnt(0)" ::: "memory");
            const unsigned og = xb_add(&bar[XB_TOP], 1u);
            const unsigned tg = og / nx;
            if (og + 1u == (tg + 1u) * nx) xb_add(&bar[XB_TOPGEN], 1u);
            else XB_SPIN(xb_ld(&bar[XB_TOPGEN]) == tg, bar);
            __builtin_amdgcn_fence(__ATOMIC_ACQUIRE, "agent");
            xb_add(&bar[XB_XGEN(b.x)], 1u);
            asm volatile("s_waitcnt vmcnt(0)" ::: "memory");
        } else {
            XB_SPIN(xb_ld(&bar[XB_XGEN(b.x)]) == gen, bar);
            __builtin_amdgcn_fence(__ATOMIC_ACQUIRE, "agent");
            asm volatile("s_waitcnt vmcnt(0)" ::: "memory");
        }
    }
    __syncthreads();
}

__global__ void __launch_bounds__(512, 2) mega(Params P) {
    extern __shared__ __attribute__((aligned(16))) unsigned char lds_raw[];
    LAS unsigned char* lds = (LAS unsigned char*)lds_raw;
    cg::grid_group grid = cg::this_grid();
    const int G = gridDim.x; int c = blockIdx.x;
    volatile LAS unsigned* bst = (volatile LAS unsigned*)(lds + LDS_BYTES - 64);
    if (threadIdx.x < 2) bst[threadIdx.x] = 0u;
    __syncthreads();
    const XcdBarrier xbar = xcd_barrier_post((unsigned*)(P.ws + WS_CTL), bst);
#define WSL() unsigned char* wsl = P.ws; asm volatile("" : "+s"(wsl))
#define s0 ((bf16_t*)(wsl + SLOT0))
#define s1 (s0 + SLOT_ELEMS)
#define s2 (s0 + 2 * SLOT_ELEMS)
#define s3 (s0 + 3 * SLOT_ELEMS)
#define s4 (s0 + 4 * SLOT_ELEMS)
#define s5 (s0 + 5 * SLOT_ELEMS)
#define s6 (s0 + 6 * SLOT_ELEMS)
#define Win ((const bf16_t*)(wsl + W_IN))
#define Wpool ((const bf16_t*)(wsl + W_POOL))
#define Wbr ((const bf16_t*)(wsl + W_BR))
#define Wout ((const bf16_t*)(wsl + W_OUT))
#define Wgu ((const bf16_t*)(wsl + W_GU))
#define Wdown ((const bf16_t*)(wsl + W_DOWN))
    const int lo = P.lo, hi = P.hi;
#define IN(k) (lo <= (k) && (k) < hi)
#ifndef PROBE_MASK
#define PROBE_MASK 0
#endif
#define PB(k) unsigned long long pt0_ = 0; if ((PROBE_MASK >> (k)) & 1) pt0_ = __builtin_amdgcn_s_memrealtime()
#define PE(k) do { if ((PROBE_MASK >> (k)) & 1) { const unsigned long long pt1_ = __builtin_amdgcn_s_memrealtime(); while (__builtin_amdgcn_s_memrealtime() - pt1_ < pt1_ - pt0_) __builtin_amdgcn_s_sleep(8); } } while (0)
#define SEAM(k) do { if (IN(k) && IN((k) + 1)) { PB(10); \
        if ((k) == 0) { xcd_barrier(xbar);     \
              \
            if (threadIdx.x == 0) { unsigned* bw_ = (unsigned*)(P.ws + WS_CTL); bool ok_ = (G % 8) == 0; \
                for (int j_ = 0; j_ < 16; ++j_) { const unsigned n_ = xb_ld(&bw_[XB_XCNT(j_)]); ok_ = ok_ && (n_ == (j_ < 8 ? (unsigned)(G / 8) : 0u)); } \
                bst[3] = ok_ ? (bst[2] * 8u + xbar.x) : (unsigned)blockIdx.x; } \
            __syncthreads(); c = (int)bst[3]; } \
        else xcd_barrier(xbar); PE(10); } } while (0)
    for (int l = 0; l < NLAYER; ++l) {
        const int pb = l * 10;
        int tid = threadIdx.x; asm volatile("" : "+v"(tid));
        const int lane = tid & 63, wave = __builtin_amdgcn_readfirstlane(tid >> 6);
        const int gw = c * 8 + wave, NGW = G * 8, gtid = c * 512 + tid, NT = G * 512;
        const float* xin = (l == 0) ? P.in[0] : P.out;
        if (IN(pb + 0)) {
            PB(0); WSL();
            convert_weights(P, l, lds, gw, NGW, wave, lane);
            rms_rows(xin, P.in[1] + (size_t)l * DM, s0, gw, NGW, lane);
            PE(0);
        }
        SEAM(pb + 0);
        if (IN(pb + 1)) {
            PB(1); WSL();
            using C1 = pg8::Cfg<MTOK, 5120, DM, DM, DM>;
            pg8::EpiInProj E{s1, s5, (LAS float*)(lds + 131072 + 1024), P.in[13] + (size_t)l * HD, P.in[14] + (size_t)l * HD};
            pg8::gemm_phase<C1>(lds, s0, Win, G, c, E);
            PE(1);
        }
        SEAM(pb + 1);
        if (IN(pb + 2)) {
            PB(2); WSL();
            lru_phase(P, l, lds, s2, G, c);
            { using C2 = pg8::Cfg<MTOK, DM, 256, DM, 256, 1, 256>;
              int tid2 = threadIdx.x; asm volatile("" : "+v"(tid2));
              pg8::Unit uu;
              for (int i = 0; pg8::next_unit<C2>(i, G, c, uu); ++i) pool_tile(s6, s1, uu.pm, uu.pn, tid2);
              __syncthreads();
              using CW = pg8::Cfg<DM, DM, 256, DM, 256, 1, 256>;
              pg8::EpiColOp<2> E{(bf16_t*)(wsl + W_EFF), DM, nullptr};
              pg8::gemm_phase<CW>(lds, Wbr, Wpool, G, c, E); }
            attn_phase(lds, s3, s4, s5, G, c);
            PE(2);
        }
        SEAM(pb + 2);
        if (IN(pb + 4)) {
            PB(4); WSL();
            pg8::EpiGateMerge E{s4 + (size_t)c * 131072, s6 + (size_t)c * 65536, s5, P.in[3] + (size_t)l * 3 * DM};
            pg8::gemm_phase<pg8::CfgGM>(lds, s0, (const bf16_t*)wsl, G, c, E);
            PE(4);
        }
        SEAM(pb + 4);
        if (IN(pb + 6)) {
            PB(6); WSL();
            using C5 = pg8::Cfg<MTOK, DM, DM, DM, DM>;
            pg8::EpiResid E{xin, P.out};
            pg8::gemm_phase<C5>(lds, s5, Wout, G, c, E);
            PE(6);
        }
        SEAM(pb + 6);
        if (IN(pb + 7)) { PB(7); WSL(); rms_rows(P.out, P.in[17] + (size_t)l * DM, s0, gw, NGW, lane); PE(7); }
        SEAM(pb + 7);
        if (IN(pb + 8)) {
            PB(8); WSL();
            using C6 = pg8::Cfg<MTOK, NGU, DM, DM, DM>;
            pg8::EpiSwiglu E{s3};
            pg8::gemm_phase<C6>(lds, s0, Wgu, G, c, E);
            PE(8);
        }
        SEAM(pb + 8);
        if (IN(pb + 9)) {
            PB(9); WSL();
            using C7 = pg8::Cfg<MTOK, DM, DFF, DFF, DFF>;
            pg8::EpiResid E{P.out, P.out};
            pg8::gemm_phase<C7>(lds, s3, Wdown, G, c, E);
            PE(9);
        }
        SEAM(pb + 9);
    }
    if (P.dbg >= 0) {
        asm volatile("s_waitcnt vmcnt(0) lgkmcnt(0)" ::: "memory"); grid.sync(); __builtin_amdgcn_fence(__ATOMIC_ACQUIRE, "agent"); asm volatile("s_waitcnt vmcnt(0)" ::: "memory");
        WSL(); const bf16_t* sl = s0 + (size_t)P.dbg * SLOT_ELEMS;
        for (size_t i = (size_t)c * 512 + threadIdx.x; i < (size_t)MTOK * DM; i += (size_t)G * 512) { float v = __uint_as_float((unsigned)sl[i] << 16) + DBG_ADD; if (!(fabsf(v) < 1e30f)) v = 12345.0f; P.out[i] = v; }
    }
#undef IN
#undef SEAM
#undef s0
#undef s1
#undef s2
#undef s3
#undef s4
#undef s5
#undef s6
#undef Win
#undef Wpool
#undef Wbr
#undef Wout
#undef Wgu
#undef Wdown
}

extern "C" void kernel_launch(void* const* d_in, const int* in_sizes, int n_in, void* d_out, int out_size, void* d_ws, size_t ws_size, hipStream_t stream) {
    static int grid = 0;
    if (grid == 0) {
        if (n_in != 21 || ws_size < WS_NEED) { fprintf(stderr, "kernel_launch: unexpected n_in %d / ws_size %zu (need %zu)\n", n_in, ws_size, (size_t)WS_NEED); grid = -1; return; }
        int dev = 0, cus = 0, per_cu = 0;
        hipGetDevice(&dev); hipDeviceGetAttribute(&cus, hipDeviceAttributeMultiprocessorCount, dev);
        if (hipFuncSetAttribute((const void*)mega, hipFuncAttributeMaxDynamicSharedMemorySize, LDS_BYTES) != hipSuccess) { fprintf(stderr, "kernel_launch: hipFuncSetAttribute failed\n"); grid = -1; return; }
        if (hipOccupancyMaxActiveBlocksPerMultiprocessor(&per_cu, (const void*)mega, 512, LDS_BYTES) != hipSuccess || per_cu < 1) { fprintf(stderr, "kernel_launch: occupancy query gave %d\n", per_cu); per_cu = 1; }
        (void)hipGetLastError();
        grid = cus * per_cu;
    }
    if (grid < 0) return;
    if (hipMemsetAsync((char*)d_ws + WS_CTL, 0, CTL_BYTES, stream) != hipSuccess) { fprintf(stderr, "kernel_launch: memset failed\n"); return; }
    Params p{};
    for (int i = 0; i < 21; ++i) p.in[i] = (const float*)d_in[i];
    p.out = (float*)d_out; p.ws = (unsigned char*)d_ws; p.lo = 0; p.hi = DBG_HI; p.dbg = DBG_SLOT;
    void* args[] = {&p};
    hipError_t e = hipLaunchCooperativeKernel((const void*)mega, dim3(grid), dim3(512), args, LDS_BYTES, stream);
    if (e != hipSuccess) fprintf(stderr, "cooperative launch failed: %s (grid %d)\n", hipGetErrorString(e), grid);
}
```
